# Optimizing an MI355X kernel written in HIP

```python
import jax, jax.numpy as jnp
from jax import lax
import numpy as np

D_MODEL = 1024
BATCH = 8
SEQ = 2048
DEPTH = 1
DEC_BATCH = 128
DEC_SEQ = 8
PAST_LEN = 16384
PAGE_SIZE = 128

D_MIX = D_MODEL
HEAD_DIM = 64
D_A = D_MIX // 2
D_B = D_MIX - D_A
N_A_HEADS = D_A // HEAD_DIM
N_Q_HEADS = D_B // HEAD_DIM
N_KV_HEADS = 2
GQA_GROUP = N_Q_HEADS // N_KV_HEADS
KV_DIM = N_KV_HEADS * HEAD_DIM
CHUNK = 128
WINDOW = 128
ROPE_THETA = 10000.0
D_FF = 2816
D_PLE = 256
EPS = 1e-6
D_IN_PROJ = 2 * D_A + D_B + 2 * KV_DIM

kernel_name = "hymba_chunkgmlp_swa_sink_macaron_step"


def _rmsnorm(x, g):
    xf = x.astype(jnp.float32)
    y = xf * lax.rsqrt(jnp.mean(xf * xf, axis=-1, keepdims=True) + EPS)
    return (y * g.astype(jnp.float32)).astype(x.dtype)


def _layernorm(x, g, b):
    xf = x.astype(jnp.float32)
    mu = jnp.mean(xf, axis=-1, keepdims=True)
    xc = xf - mu
    y = xc * lax.rsqrt(jnp.mean(xc * xc, axis=-1, keepdims=True) + EPS)
    return (y * g.astype(jnp.float32) + b.astype(jnp.float32)).astype(x.dtype)


def _swiglu(x, w_gate, w_up, w_down):
    return (jax.nn.silu(x @ w_gate) * (x @ w_up)) @ w_down


def _rope(x, pos):
    half = HEAD_DIM // 2
    inv = ROPE_THETA ** (-jnp.arange(half, dtype=jnp.float32) / half)
    ang = pos.astype(jnp.float32)[:, None] * inv[None, :]
    cos = jnp.cos(ang)[:, None, :]
    sin = jnp.sin(ang)[:, None, :]
    xf = x.astype(jnp.float32)
    x1, x2 = xf[..., :half], xf[..., half:]
    out = jnp.concatenate([x1 * cos - x2 * sin, x2 * cos + x1 * sin], axis=-1)
    return out.astype(x.dtype)


def _chunk_mix(u, v, w_s, b_s):
    n, t = v.shape[:2]
    n_chunks = -(-t // CHUNK)
    pad = n_chunks * CHUNK - t
    vp = jnp.pad(v, ((0, 0), (0, pad), (0, 0), (0, 0)))
    vp = vp.reshape(n, n_chunks, CHUNK, N_A_HEADS, HEAD_DIM)
    causal = jnp.tril(jnp.ones((CHUNK, CHUNK), dtype=bool))
    w = jnp.where(causal[None], w_s, 0)
    mixed = jnp.einsum('hts,ncshd->ncthd', w, vp) + b_s.T[None, None, :, :, None]
    mixed = mixed.reshape(n, n_chunks * CHUNK, N_A_HEADS, HEAD_DIM)[:, :t]
    return u * mixed


def _window_mask(qpos, kpos):
    d = qpos[..., :, None] - kpos[..., None, :]
    return (d >= 0) & (d < WINDOW) & (kpos[..., None, :] >= 0)


def _sink_attention(q, k, v, mask, sinks):
    scale = HEAD_DIM ** -0.5
    s = jnp.einsum('nbqkgd,nbskd->nbkgqs', q, k).astype(jnp.float32) * scale
    s = jnp.where(mask[None, :, None, None], s, -jnp.inf)
    sink = sinks.astype(jnp.float32)[None, None, :, :, None, None]
    m = jnp.maximum(jnp.max(s, axis=-1, keepdims=True), sink)
    p = jnp.exp(s - m)
    denom = jnp.sum(p, axis=-1, keepdims=True) + jnp.exp(sink - m)
    w = (p / denom).astype(v.dtype)
    return jnp.einsum('nbkgqs,nbskd->nbqkgd', w, v)


def _window_attention_prompt(q, k, v, sinks):
    b, s = q.shape[:2]
    nb = -(-s // WINDOW)
    pad = nb * WINDOW - s
    qb = jnp.pad(q, ((0, 0), (0, pad), (0, 0), (0, 0)))
    qb = qb.reshape(b, nb, WINDOW, N_KV_HEADS, GQA_GROUP, HEAD_DIM)
    kb = jnp.pad(k, ((0, 0), (WINDOW, pad), (0, 0), (0, 0))).reshape(b, nb + 1, WINDOW, N_KV_HEADS, HEAD_DIM)
    vb = jnp.pad(v, ((0, 0), (WINDOW, pad), (0, 0), (0, 0))).reshape(b, nb + 1, WINDOW, N_KV_HEADS, HEAD_DIM)
    kband = jnp.concatenate([kb[:, :-1], kb[:, 1:]], axis=2)
    vband = jnp.concatenate([vb[:, :-1], vb[:, 1:]], axis=2)
    blk = jnp.arange(nb)[:, None]
    qpos = blk * WINDOW + jnp.arange(WINDOW)[None, :]
    kpos = (blk - 1) * WINDOW + jnp.arange(2 * WINDOW)[None, :]
    mask = _window_mask(qpos, kpos)
    o = _sink_attention(qb, kband, vband, mask, sinks)
    return o.reshape(b, nb * WINDOW, N_Q_HEADS, HEAD_DIM)[:, :s]


def _window_attention_sample(q, k_new, v_new, k_buf, v_buf, sinks):
    n, t = q.shape[:2]
    buf_len = k_buf.shape[1]
    k_all = jnp.concatenate([k_buf, k_new], axis=1)
    v_all = jnp.concatenate([v_buf, v_new], axis=1)
    qpos = PAST_LEN + jnp.arange(t)
    kpos = PAST_LEN - buf_len + jnp.arange(buf_len + t)
    mask = _window_mask(qpos, kpos)[None]
    qb = q.reshape(n, 1, t, N_KV_HEADS, GQA_GROUP, HEAD_DIM)
    o = _sink_attention(qb, k_all[:, None], v_all[:, None], mask, sinks)
    return o.reshape(n, t, N_Q_HEADS, HEAD_DIM), k_all[:, -buf_len:], v_all[:, -buf_len:]


def _layer(x, pe, pos, lp, k_buf=None, v_buf=None):
    n, t = x.shape[:2]
    x = x + 0.5 * _swiglu(_rmsnorm(x, lp['g_ffn1']), lp['w_ffn1_gate'], lp['w_ffn1_up'], lp['w_ffn1_down'])
    h = _rmsnorm(x, lp['g_mix'])
    z = h @ lp['w_in']
    ua, va, q, k, v = jnp.split(z, [D_A, 2 * D_A, 2 * D_A + D_B, 2 * D_A + D_B + KV_DIM], axis=-1)
    ua = jax.nn.gelu(ua)
    va = _layernorm(jax.nn.gelu(va), lp['g_a_v'], lp['b_a_v'])
    a_out = _chunk_mix(ua.reshape(n, t, N_A_HEADS, HEAD_DIM), va.reshape(n, t, N_A_HEADS, HEAD_DIM),
                       lp['w_s'], lp['b_s']).reshape(n, t, D_A)
    chunk_state = va[:, ((t - 1) // CHUNK) * CHUNK:]
    q = _rope(_rmsnorm(q.reshape(n, t, N_Q_HEADS, HEAD_DIM), lp['g_q']), pos)
    k = _rope(_rmsnorm(k.reshape(n, t, N_KV_HEADS, HEAD_DIM), lp['g_k']), pos)
    v = v.reshape(n, t, N_KV_HEADS, HEAD_DIM)
    sinks = lp['sinks'].reshape(N_KV_HEADS, GQA_GROUP)
    if k_buf is None:
        o = _window_attention_prompt(q, k, v, sinks)
        k_state, v_state = k[:, -WINDOW:], v[:, -WINDOW:]
    else:
        o, k_state, v_state = _window_attention_sample(q, k, v, k_buf, v_buf, sinks)
    b_out = o.reshape(n, t, D_B)
    mix = jnp.concatenate([_rmsnorm(a_out, lp['g_out_a']), _rmsnorm(b_out, lp['g_out_b'])], axis=-1)
    x = x + mix @ lp['w_o']
    x = x + 0.5 * _swiglu(_rmsnorm(x, lp['g_ffn2']), lp['w_ffn2_gate'], lp['w_ffn2_up'], lp['w_ffn2_down'])
    gate = jax.nn.sigmoid(_rmsnorm(x, lp['g_ple']) @ lp['w_ple_gate'])
    x = x + gate * (pe @ lp['w_ple_proj'])
    return x, k_state, v_state, chunk_state


def setup_inputs(seed: int = 0) -> dict:
    key = jax.random.key(seed)
    ks = jax.random.split(key, 32)
    f32 = jnp.float32
    buf_len = min(WINDOW, PAST_LEN)

    def nrm(k, shape, scale=1.0):
        return jax.random.normal(k, shape, f32) * scale

    def gain(k, shape):
        return 1.0 + 0.1 * jax.random.normal(k, shape, f32)

    L = DEPTH
    return {
        "x_prompt": nrm(ks[0], (BATCH, SEQ, D_MODEL)),
        "x_sample": nrm(ks[1], (DEC_BATCH, DEC_SEQ, D_MODEL)),
        "p_prompt": nrm(ks[2], (DEPTH, BATCH, SEQ, D_PLE)),
        "p_sample": nrm(ks[3], (DEPTH, DEC_BATCH, DEC_SEQ, D_PLE)),
        "cache_k_win": nrm(ks[4], (DEPTH, DEC_BATCH, buf_len, N_KV_HEADS, HEAD_DIM)),
        "cache_v_win": nrm(ks[5], (DEPTH, DEC_BATCH, buf_len, N_KV_HEADS, HEAD_DIM)),
        "g_ffn1": gain(ks[6], (L, D_MODEL)),
        "w_ffn1_gate": nrm(ks[7], (L, D_MODEL, D_FF), D_MODEL ** -0.5),
        "w_ffn1_up": nrm(ks[8], (L, D_MODEL, D_FF), D_MODEL ** -0.5),
        "w_ffn1_down": nrm(ks[9], (L, D_FF, D_MODEL), D_FF ** -0.5),
        "g_mix": gain(ks[10], (L, D_MODEL)),
        "w_in": nrm(ks[11], (L, D_MODEL, D_IN_PROJ), D_MODEL ** -0.5),
        "g_a_v": gain(ks[12], (L, D_A)),
        "b_a_v": nrm(ks[13], (L, D_A), 0.1),
        "w_s": nrm(ks[14], (L, N_A_HEADS, CHUNK, CHUNK), CHUNK ** -0.5),
        "b_s": gain(ks[15], (L, N_A_HEADS, CHUNK)),
        "g_q": gain(ks[16], (L, HEAD_DIM)),
        "g_k": gain(ks[17], (L, HEAD_DIM)),
        "sinks": nrm(ks[18], (L, N_Q_HEADS)),
        "g_out_a": gain(ks[19], (L, D_A)),
        "g_out_b": gain(ks[20], (L, D_B)),
        "w_o": nrm(ks[21], (L, D_MIX, D_MODEL), D_MIX ** -0.5),
        "g_ffn2": gain(ks[22], (L, D_MODEL)),
        "w_ffn2_gate": nrm(ks[23], (L, D_MODEL, D_FF), D_MODEL ** -0.5),
        "w_ffn2_up": nrm(ks[24], (L, D_MODEL, D_FF), D_MODEL ** -0.5),
        "w_ffn2_down": nrm(ks[25], (L, D_FF, D_MODEL), D_FF ** -0.5),
        "g_ple": gain(ks[26], (L, D_MODEL)),
        "w_ple_gate": nrm(ks[27], (L, D_MODEL, D_MODEL), D_MODEL ** -0.5),
        "w_ple_proj": nrm(ks[28], (L, D_PLE, D_MODEL), D_PLE ** -0.5),
    }


def reference(x_prompt, x_sample, p_prompt, p_sample, cache_k_win, cache_v_win,
              g_ffn1, w_ffn1_gate, w_ffn1_up, w_ffn1_down, g_mix, w_in, g_a_v, b_a_v,
              w_s, b_s, g_q, g_k, sinks, g_out_a, g_out_b, w_o, g_ffn2, w_ffn2_gate,
              w_ffn2_up, w_ffn2_down, g_ple, w_ple_gate, w_ple_proj):
    pos_p = jnp.arange(x_prompt.shape[1])
    pos_s = PAST_LEN + jnp.arange(x_sample.shape[1])
    yp, ys = x_prompt, x_sample
    pk, pv, pa, sk, sv, sa = [], [], [], [], [], []
    for i in range(DEPTH):
        lp = dict(g_ffn1=g_ffn1[i], w_ffn1_gate=w_ffn1_gate[i], w_ffn1_up=w_ffn1_up[i],
                  w_ffn1_down=w_ffn1_down[i], g_mix=g_mix[i], w_in=w_in[i], g_a_v=g_a_v[i],
                  b_a_v=b_a_v[i], w_s=w_s[i], b_s=b_s[i], g_q=g_q[i], g_k=g_k[i], sinks=sinks[i],
                  g_out_a=g_out_a[i], g_out_b=g_out_b[i], w_o=w_o[i], g_ffn2=g_ffn2[i],
                  w_ffn2_gate=w_ffn2_gate[i], w_ffn2_up=w_ffn2_up[i], w_ffn2_down=w_ffn2_down[i],
                  g_ple=g_ple[i], w_ple_gate=w_ple_gate[i], w_ple_proj=w_ple_proj[i])
        yp, k1, v1, a1 = _layer(yp, p_prompt[i], pos_p, lp)
        ys, k2, v2, a2 = _layer(ys, p_sample[i], pos_s, lp, cache_k_win[i], cache_v_win[i])
        pk.append(k1); pv.append(v1); pa.append(a1)
        sk.append(k2); sv.append(v2); sa.append(a2)
    return (yp, ys, jnp.stack(pk), jnp.stack(pv), jnp.stack(pa),
            jnp.stack(sk), jnp.stack(sv), jnp.stack(sa))
```

```cpp
#include <hip/hip_runtime.h>
#include <hip/hip_cooperative_groups.h>
#include <cstdio>
#include <cstdint>
#include <cmath>
namespace cg = cooperative_groups;
namespace pg8 {
#define PG8_LAS __attribute__((address_space(3)))
typedef unsigned short bf16_t;
typedef short bf16x8 __attribute__((ext_vector_type(8)));
typedef float f32x4 __attribute__((ext_vector_type(4)));
typedef unsigned u32x4 __attribute__((ext_vector_type(4)));
constexpr int BM = 256, BK = 64, HALF = 128, HTB = HALF * BK * 2  , STAGE_BYTES = 8 * HTB, NXCD = 8, WGM = 8;

__host__ __device__ __forceinline__ int lds_byte(int r, int c) { const int st = (r >> 4) * 2 + (c >> 5), rr = r & 15, cc = c & 31, ob = rr * 64 + cc * 2; return st * 1024 + (ob ^ (((ob >> 9) & 1) << 5)); }
__host__ __device__ __forceinline__ void stage_rc(int b, int& R, int& C) { const int st = b / 1024, sb = b % 1024, swz = sb ^ (((sb >> 9) & 1) << 5); R = (st >> 1) * 16 + swz / 64; C = (st & 1) * 32 + (swz % 64) / 2; }
__host__ __device__ __forceinline__ int perm32(int rho) { const int n = rho >> 4, i = rho & 15; return 8 * (i >> 2) + 4 * n + (i & 3); }

struct Unit { int pm, pn; };
struct Gemm { const bf16_t* A; const bf16_t* Bt; int M, N, K; };

struct StaticOrder {
    int nM, nN, nwg, G, c;
    __host__ __device__ void init(int M, int N, int G_, int c_) { nM = M / BM; nN = N / BM; nwg = nM * nN; G = G_; c = c_; }
    __host__ __device__ bool next(int i, Unit& u) const {
        const long L = (long)i * G + c; if (L >= nwg) return false;
        int wgid = (int)L; { const int q = nwg / NXCD, r = nwg % NXCD, xcd = wgid % NXCD, off = wgid / NXCD; wgid = (xcd < r ? xcd * (q + 1) : r * (q + 1) + (xcd - r) * q) + off; }
        const int nig = WGM * nN, gid = wgid / nig, fm = gid * WGM, gsz = (nM - fm) < WGM ? (nM - fm) : WGM;
        u.pm = fm + ((wgid % nig) % gsz); u.pn = (wgid % nig) / gsz; return true;
    }
    __device__ __forceinline__ void a_ready(const Unit&) const {}
    __device__ __forceinline__ void done(const Unit&) const {}
};

struct RangeOrder {
    int first, last;
    __host__ __device__ bool next(int i, Unit& u) const { const int idx = first + i; if (idx >= last) return false; u.pm = idx >> 2; u.pn = idx & 3; return true; }
    __device__ __forceinline__ void a_ready(const Unit&) const {}
    __device__ __forceinline__ void done(const Unit&) const {}
};

__device__ __forceinline__ unsigned cvt_pk_bf16(float lo, float hi) { unsigned r; asm volatile("v_cvt_pk_bf16_f32 %0, %1, %2" : "=v"(r) : "v"(lo), "v"(hi)); return r; }
typedef float f32x2 __attribute__((ext_vector_type(2)));
__device__ __forceinline__ float fast_rcp(float x) { return __builtin_amdgcn_rcpf(x); }
__device__ __forceinline__ float row_rs(const float* SS, int r) {
    const f32x4* p = (const f32x4*)(SS + (size_t)r * 16);
    const f32x4 a = p[0], b = p[1], c = p[2], d = p[3];
    const f32x4 s = (a + b) + (c + d);
    const float t = (s[0] + s[1]) + (s[2] + s[3]);
    return __builtin_amdgcn_rsqf(t * (1.0f / 1024.0f) + 1e-6f);
}
__device__ __forceinline__ void row_rs8(const float* SS, int row0, int fq, float (&rsv)[2][4]) {
    f32x4 q[2][4];
#pragma unroll
    for (int ai = 0; ai < 2; ++ai)
#pragma unroll
        for (int m = 0; m < 4; ++m) q[ai][m] = *(const f32x4*)(SS + (size_t)(row0 + ai * HALF + m * 16) * 16 + 4 * fq);
#pragma unroll
    for (int ai = 0; ai < 2; ++ai)
#pragma unroll
        for (int m = 0; m < 4; ++m) { float t = (q[ai][m][0] + q[ai][m][1]) + (q[ai][m][2] + q[ai][m][3]); t += __shfl_xor(t, 16); t += __shfl_xor(t, 32); rsv[ai][m] = __builtin_amdgcn_rsqf(t * (1.0f / 1024.0f) + 1e-6f); }
}
struct EpiAct {
    static constexpr bool PERM = true, AFTER_DRAIN = false;
    bf16_t* O; const float* SS; int ldo;
    __device__ __forceinline__ void operator()(const f32x4 (&acc)[2][2][4][2], const Unit& u, int wr, int wc, int fr, int fq) const {
        const int row0 = u.pm * BM + wr * 64 + fr, col0 = u.pn * HALF + wc * 32 + 8 * fq;
        float rsv[2][4]; row_rs8(SS, row0, fq, rsv);
#pragma unroll
        for (int ai = 0; ai < 2; ++ai)
#pragma unroll
            for (int m = 0; m < 4; ++m) {
                const int r = row0 + ai * HALF + m * 16; const float rs = rsv[ai][m], nrs = rs * -1.4426950408889634f, rs2 = rs * rs;
                float o[8];
#pragma unroll
                for (int n = 0; n < 2; ++n) {
                    const f32x4 t = acc[ai][0][m][n] * nrs, p = (acc[ai][0][m][n] * acc[ai][1][m][n]) * rs2;
#pragma unroll
                    for (int j = 0; j < 4; ++j) o[4 * n + j] = p[j] * fast_rcp(1.0f + __builtin_amdgcn_exp2f(t[j]));
                }
                u32x4 w; w.x = cvt_pk_bf16(o[0], o[1]); w.y = cvt_pk_bf16(o[2], o[3]); w.z = cvt_pk_bf16(o[4], o[5]); w.w = cvt_pk_bf16(o[6], o[7]);
                *(u32x4*)(O + (size_t)r * ldo + col0) = w;
            }
    }
};
struct EpiRes {
    static constexpr bool PERM = true, AFTER_DRAIN = false;
    bf16_t* XB; float* SS; float alpha;
    __device__ __forceinline__ void operator()(const f32x4 (&acc)[2][2][4][2], const Unit& u, int wr, int wc, int fr, int fq) const {
        const int row0 = u.pm * BM + wr * 64 + fr, col0 = u.pn * BM + wc * 32 + 8 * fq;
        u32x4 rb[2][4][2];
#pragma unroll
        for (int ai = 0; ai < 2; ++ai)
#pragma unroll
            for (int m = 0; m < 4; ++m) { const bf16_t* xq = XB + (size_t)(row0 + ai * HALF + m * 16) * 1024 + col0; rb[ai][m][0] = *(const u32x4*)xq; rb[ai][m][1] = *(const u32x4*)(xq + HALF); }
#pragma unroll
        for (int ai = 0; ai < 2; ++ai) {
#pragma unroll
            for (int m = 0; m < 4; ++m) {
                const int r = row0 + ai * HALF + m * 16;
                bf16_t* xp = XB + (size_t)r * 1024 + col0;
                const u32x4 b0 = rb[ai][m][0], b1 = rb[ai][m][1];
                float ss = 0.f;
#pragma unroll
                for (int bj = 0; bj < 2; ++bj) {
                    const u32x4 b = bj ? b1 : b0;
                    f32x4 v0, v1;
                    v0[0] = __uint_as_float(b.x << 16); v0[1] = __uint_as_float(b.x & 0xffff0000u); v0[2] = __uint_as_float(b.y << 16); v0[3] = __uint_as_float(b.y & 0xffff0000u);
                    v1[0] = __uint_as_float(b.z << 16); v1[1] = __uint_as_float(b.z & 0xffff0000u); v1[2] = __uint_as_float(b.w << 16); v1[3] = __uint_as_float(b.w & 0xffff0000u);
                    v0 += acc[ai][bj][m][0] * alpha; v1 += acc[ai][bj][m][1] * alpha;
                    ss += (v0[0] * v0[0] + v0[1] * v0[1]) + (v0[2] * v0[2] + v0[3] * v0[3]) + (v1[0] * v1[0] + v1[1] * v1[1]) + (v1[2] * v1[2] + v1[3] * v1[3]);
                    u32x4 w; w.x = cvt_pk_bf16(v0[0], v0[1]); w.y = cvt_pk_bf16(v0[2], v0[3]); w.z = cvt_pk_bf16(v1[0], v1[1]); w.w = cvt_pk_bf16(v1[2], v1[3]);
                    *(u32x4*)(xp + bj * HALF) = w;
                }
                ss += __shfl_xor(ss, 16); ss += __shfl_xor(ss, 32);
                if (fq == 0) SS[(size_t)r * 16 + u.pn * 4 + wc] = ss;
            }
        }
    }
};
struct EpiZ {
    static constexpr bool PERM = true, AFTER_DRAIN = false;
    bf16_t* O; const float* SS; int ldo, gelu_tiles;
    __device__ __forceinline__ void operator()(const f32x4 (&acc)[2][2][4][2], const Unit& u, int wr, int wc, int fr, int fq) const {
        const int row0 = u.pm * BM + wr * 64 + fr, col0 = u.pn * BM + wc * 32 + 8 * fq;
        float rsv[2][4]; row_rs8(SS, row0, fq, rsv);
#pragma unroll
        for (int ai = 0; ai < 2; ++ai)
#pragma unroll
            for (int m = 0; m < 4; ++m) {
                const int r = row0 + ai * HALF + m * 16; const float rs = rsv[ai][m];
#pragma unroll
                for (int bj = 0; bj < 2; ++bj) {
                    f32x4 a = acc[ai][bj][m][0] * rs, b = acc[ai][bj][m][1] * rs;
                    if (u.pn < gelu_tiles) {
#pragma unroll
                        for (int j = 0; j < 4; ++j) { const float ua = 1.5957691216057308f * a[j] * (1.0f + 0.044715f * a[j] * a[j]), ub = 1.5957691216057308f * b[j] * (1.0f + 0.044715f * b[j] * b[j]);
                            a[j] = a[j] * fast_rcp(1.0f + __expf(-ua)); b[j] = b[j] * fast_rcp(1.0f + __expf(-ub)); }
                    }
                    u32x4 w; w.x = cvt_pk_bf16(a[0], a[1]); w.y = cvt_pk_bf16(a[2], a[3]); w.z = cvt_pk_bf16(b[0], b[1]); w.w = cvt_pk_bf16(b[2], b[3]);
                    *(u32x4*)(O + (size_t)r * ldo + col0 + bj * HALF) = w;
                }
            }
    }
};
struct EpiBf {
    static constexpr bool PERM = true, AFTER_DRAIN = false;
    bf16_t* P;
    __device__ __forceinline__ void operator()(const f32x4 (&acc)[2][2][4][2], const Unit& u, int wr, int wc, int fr, int fq) const {
        const int row0 = u.pm * BM + wr * 64 + fr, col0 = u.pn * BM + wc * 32 + 8 * fq;
#pragma unroll
        for (int ai = 0; ai < 2; ++ai)
#pragma unroll
            for (int m = 0; m < 4; ++m) {
                const int r = row0 + ai * HALF + m * 16;
#pragma unroll
                for (int bj = 0; bj < 2; ++bj) { const f32x4 a = acc[ai][bj][m][0], b = acc[ai][bj][m][1];
                    u32x4 w; w.x = cvt_pk_bf16(a[0], a[1]); w.y = cvt_pk_bf16(a[2], a[3]); w.z = cvt_pk_bf16(b[0], b[1]); w.w = cvt_pk_bf16(b[2], b[3]);
                    *(u32x4*)(P + (size_t)r * 1024 + col0 + bj * HALF) = w; }
            }
    }
};
struct EpiPle {
    static constexpr bool PERM = true, AFTER_DRAIN = false;
    const bf16_t* XB; const bf16_t* P; float* Y; const float* SS;
    __device__ __forceinline__ void operator()(const f32x4 (&acc)[2][2][4][2], const Unit& u, int wr, int wc, int fr, int fq) const {
        const int row0 = u.pm * BM + wr * 64 + fr, col0 = u.pn * BM + wc * 32 + 8 * fq;
        float rsv[2][4]; row_rs8(SS, row0, fq, rsv);
#pragma unroll
        for (int ai = 0; ai < 2; ++ai)
#pragma unroll
            for (int mp = 0; mp < 2; ++mp) {
                u32x4 xr[2][2], pr[2][2];
#pragma unroll
                for (int mm = 0; mm < 2; ++mm)
#pragma unroll
                    for (int bj = 0; bj < 2; ++bj) { const size_t off = (size_t)(row0 + ai * HALF + (2 * mp + mm) * 16) * 1024 + col0 + bj * HALF; xr[mm][bj] = *(const u32x4*)(XB + off); pr[mm][bj] = *(const u32x4*)(P + off); }
#pragma unroll
                for (int mm = 0; mm < 2; ++mm) {
                    const int m = 2 * mp + mm; const int r = row0 + ai * HALF + m * 16; const float nrs = rsv[ai][m] * -1.4426950408889634f;
#pragma unroll
                    for (int bj = 0; bj < 2; ++bj) {
                        const size_t off = (size_t)r * 1024 + col0 + bj * HALF;
                        const unsigned xw[4] = {xr[mm][bj].x, xr[mm][bj].y, xr[mm][bj].z, xr[mm][bj].w}, pw[4] = {pr[mm][bj].x, pr[mm][bj].y, pr[mm][bj].z, pr[mm][bj].w};
                        f32x4 o[2];
#pragma unroll
                        for (int q = 0; q < 4; ++q) {
                            const float t0 = acc[ai][bj][m][q >> 1][2 * (q & 1)] * nrs, t1 = acc[ai][bj][m][q >> 1][2 * (q & 1) + 1] * nrs;
                            o[q >> 1][2 * (q & 1)] = __uint_as_float(xw[q] << 16) + fast_rcp(1.0f + __builtin_amdgcn_exp2f(t0)) * __uint_as_float(pw[q] << 16);
                            o[q >> 1][2 * (q & 1) + 1] = __uint_as_float(xw[q] & 0xffff0000u) + fast_rcp(1.0f + __builtin_amdgcn_exp2f(t1)) * __uint_as_float(pw[q] & 0xffff0000u);
                        }
                        *(f32x4*)(Y + off) = o[0]; *(f32x4*)(Y + off + 4) = o[1];
                    }
                }
            }
    }
};

template <class Epi, class Sched, bool ALIGN_EPI = false, bool SP2 = false>
__device__ __forceinline__ void gemm_phase(PG8_LAS unsigned char* lds, const Gemm g, const Sched& S, const Epi& E) {
    int tid_ = threadIdx.x; asm volatile("" : "+v"(tid_));
    const int tid = tid_, wid = __builtin_amdgcn_readfirstlane(tid >> 6), lane = tid & 63, wr = wid >> 2, wc = wid & 3, fr = lane & 15, fq = lane >> 4;
    int K_ = g.K; asm volatile("" : "+s"(K_));
    const int K = K_, nt = K / BK;
    unsigned voffA[2], voffB[2];
#pragma unroll
    for (int i = 0; i < 2; ++i) { int R, C; stage_rc(tid * 16 + i * 8192, R, C); const int Rb = Epi::PERM ? ((R & ~31) + perm32(R & 31)) : R;
        voffA[i] = (unsigned)(R * K + C) * 2u; voffB[i] = (unsigned)(Rb * K + C) * 2u; }
    const size_t kstep = (size_t)(BK * 2);
    const size_t hstep = (size_t)HALF * K * 2;
    const size_t tstep = 2 * hstep;
    const unsigned ldsw = (unsigned)wid * 1024u;
    const int aoff = lds_byte(wr * 64 + fr, fq * 8), boff = lds_byte(wc * 32 + fr, fq * 8);
#define PG8_SA(b, h) (((b) * 2 + (h)) * HTB)
#define PG8_SB(b, h) ((4 + (b) * 2 + (h)) * HTB)
#define PG8_STAGE(bufoff, gbase, voff) do { _Pragma("unroll") for (int _i = 0; _i < 2; ++_i) \
        __builtin_amdgcn_global_load_lds((const unsigned*)((const char*)(gbase) + (voff)[_i]), (PG8_LAS unsigned*)(lds + (bufoff) + ldsw + _i * 8192), 16, 0, 0); } while (0)
#define PG8_LDA(dst, b, h) do { _Pragma("unroll") for (int m = 0; m < 4; ++m) _Pragma("unroll") for (int k = 0; k < 2; ++k) dst[m][k] = *(const PG8_LAS bf16x8*)(lds + PG8_SA(b, h) + aoff + m * 2048 + k * 1024); } while (0)
#define PG8_LDB(dst, b, h) do { _Pragma("unroll") for (int n = 0; n < 2; ++n) _Pragma("unroll") for (int k = 0; k < 2; ++k) dst[n][k] = *(const PG8_LAS bf16x8*)(lds + PG8_SB(b, h) + boff + n * 2048 + k * 1024); } while (0)
#define PG8_MMA(ai, bj, At, Bt) do { __builtin_amdgcn_s_setprio(1); _Pragma("unroll") for (int m = 0; m < 4; ++m) _Pragma("unroll") for (int n = 0; n < 2; ++n) _Pragma("unroll") for (int k = 0; k < 2; ++k) \
        acc[ai][bj][m][n] = __builtin_amdgcn_mfma_f32_16x16x32_bf16(Bt[n][k], At[m][k], acc[ai][bj][m][n], 0, 0, 0); __builtin_amdgcn_s_setprio(0); } while (0)
#define PG8_WAIT_V(n) asm volatile("s_waitcnt vmcnt(" #n ")" ::: "memory")
#define PG8_WAIT_L(n) asm volatile("s_waitcnt lgkmcnt(" #n ")" ::: "memory")
#define PG8_BAR __builtin_amdgcn_s_barrier()
#define PG8_SCHED __builtin_amdgcn_sched_barrier(0)
    Unit cur, nxt; int ui = 0;
    if (!S.next(0, cur)) return;
    f32x4 acc[2][2][4][2];
#pragma unroll
    for (int a = 0; a < 2; ++a)
#pragma unroll
        for (int b = 0; b < 2; ++b)
#pragma unroll
            for (int m = 0; m < 4; ++m)
#pragma unroll
                for (int n = 0; n < 2; ++n) acc[a][b][m][n] = (f32x4){0.f, 0.f, 0.f, 0.f};
    bf16x8 At[4][2], B0[2][2], B1[2][2];
    const char* cA = (const char*)g.A + (size_t)cur.pm * tstep; const char* cB = (const char*)g.Bt + (size_t)cur.pn * tstep;
    S.a_ready(cur);
    if constexpr (SP2) {
        PG8_STAGE(PG8_SB(0, 0), cB, voffB); PG8_STAGE(PG8_SB(0, 1), cB + hstep, voffB); PG8_STAGE(PG8_SA(0, 0), cA, voffA); PG8_STAGE(PG8_SA(0, 1), cA + hstep, voffA);
        if (wr == 1) PG8_BAR;
        PG8_WAIT_V(2); PG8_BAR;
        PG8_STAGE(PG8_SB(1, 0), cB + kstep, voffB); PG8_STAGE(PG8_SA(1, 0), cA + kstep, voffA); PG8_STAGE(PG8_SB(1, 1), cB + hstep + kstep, voffB);
        PG8_WAIT_V(6); PG8_BAR;
    } else {
        PG8_STAGE(PG8_SB(0, 0), cB, voffB); PG8_STAGE(PG8_SA(0, 0), cA, voffA); PG8_STAGE(PG8_SB(0, 1), cB + hstep, voffB); PG8_STAGE(PG8_SA(0, 1), cA + hstep, voffA);
        if (wr == 1) PG8_BAR;
        PG8_WAIT_V(4); PG8_BAR;
        PG8_STAGE(PG8_SB(1, 0), cB + kstep, voffB); PG8_STAGE(PG8_SA(1, 0), cA + kstep, voffA); PG8_STAGE(PG8_SB(1, 1), cB + hstep + kstep, voffB);
        PG8_WAIT_V(6); PG8_BAR;
    }
    for (;;) {
        const bool has_next = S.next(ui + 1, nxt);
        const char* nA = has_next ? (const char*)g.A + (size_t)nxt.pm * tstep : cA; const char* nB = has_next ? (const char*)g.Bt + (size_t)nxt.pn * tstep : cB;
        for (int t = 0; t < nt; t += 2) {
            const bool last = (t == nt - 2);
            const char* a1 = cA + (size_t)(t + 1) * kstep;
            const char* a2 = last ? nA : cA + (size_t)(t + 2) * kstep; const char* b2 = last ? nB : cB + (size_t)(t + 2) * kstep;
            const char* a3 = a2 + kstep; const char* b3 = b2 + kstep;
            if (last && has_next) S.a_ready(nxt);
            if constexpr (SP2) {
            PG8_LDB(B0, 0, 0); PG8_LDB(B1, 0, 1); PG8_SCHED; PG8_LDA(At, 0, 0); PG8_STAGE(PG8_SA(1, 1), a1 + hstep, voffA);
            PG8_WAIT_V(8); PG8_WAIT_L(0); PG8_BAR; PG8_MMA(0, 0, At, B0); PG8_MMA(0, 1, At, B1); PG8_BAR; PG8_SCHED;
            PG8_LDA(At, 0, 1); PG8_STAGE(PG8_SB(0, 0), b2, voffB); PG8_STAGE(PG8_SB(0, 1), b2 + hstep, voffB); PG8_STAGE(PG8_SA(0, 0), a2, voffA);
            PG8_WAIT_V(8); PG8_WAIT_L(0); PG8_BAR; PG8_MMA(1, 0, At, B0); PG8_MMA(1, 1, At, B1); PG8_BAR; PG8_SCHED;
            PG8_LDB(B0, 1, 0); PG8_LDB(B1, 1, 1); PG8_SCHED; PG8_LDA(At, 1, 0); PG8_STAGE(PG8_SA(0, 1), a2 + hstep, voffA);
            PG8_WAIT_V(8); PG8_WAIT_L(0); PG8_BAR; PG8_MMA(0, 0, At, B0); PG8_MMA(0, 1, At, B1); PG8_BAR; PG8_SCHED;
            PG8_LDA(At, 1, 1); PG8_STAGE(PG8_SB(1, 0), b3, voffB); PG8_STAGE(PG8_SB(1, 1), b3 + hstep, voffB); PG8_STAGE(PG8_SA(1, 0), a3, voffA);
            PG8_WAIT_V(8); PG8_WAIT_L(0); PG8_BAR; PG8_MMA(1, 0, At, B0); PG8_MMA(1, 1, At, B1); PG8_BAR; PG8_SCHED;
            } else {
            PG8_LDB(B0, 0, 0); PG8_SCHED; PG8_LDA(At, 0, 0); PG8_STAGE(PG8_SA(1, 1), a1 + hstep, voffA);
            PG8_WAIT_L(8); PG8_BAR; PG8_WAIT_L(0); PG8_MMA(0, 0, At, B0); PG8_BAR; PG8_SCHED;
            PG8_LDB(B1, 0, 1); PG8_STAGE(PG8_SB(0, 0), b2, voffB);
            PG8_BAR; PG8_WAIT_L(0); PG8_MMA(0, 1, At, B1); PG8_BAR;
            PG8_LDA(At, 0, 1); PG8_STAGE(PG8_SA(0, 0), a2, voffA);
            PG8_BAR; PG8_WAIT_L(0); PG8_MMA(1, 0, At, B0); PG8_BAR; PG8_SCHED;
            PG8_STAGE(PG8_SB(0, 1), b2 + hstep, voffB);
            PG8_WAIT_V(6); PG8_BAR; PG8_MMA(1, 1, At, B1); PG8_BAR;
            PG8_LDB(B0, 1, 0); PG8_SCHED; PG8_LDA(At, 1, 0); PG8_STAGE(PG8_SA(0, 1), a2 + hstep, voffA);
            PG8_WAIT_L(8); PG8_BAR; PG8_WAIT_L(0); PG8_MMA(0, 0, At, B0); PG8_BAR; PG8_SCHED;
            PG8_LDB(B1, 1, 1); PG8_STAGE(PG8_SB(1, 0), b3, voffB);
            PG8_BAR; PG8_WAIT_L(0); PG8_MMA(0, 1, At, B1); PG8_BAR;
            PG8_LDA(At, 1, 1); PG8_STAGE(PG8_SA(1, 0), a3, voffA);
            PG8_BAR; PG8_WAIT_L(0); PG8_MMA(1, 0, At, B0); PG8_BAR; PG8_SCHED;
            PG8_STAGE(PG8_SB(1, 1), b3 + hstep, voffB);
            PG8_WAIT_V(6); PG8_BAR; PG8_MMA(1, 1, At, B1); PG8_BAR;
            }
        }
        if constexpr (ALIGN_EPI) { if (wr == 0) PG8_BAR; }
        if constexpr (!Epi::AFTER_DRAIN) { E(acc, cur, wr, wc, fr, fq); S.done(cur); }
        if (!has_next) break;
#pragma unroll
        for (int a = 0; a < 2; ++a)
#pragma unroll
            for (int b = 0; b < 2; ++b)
#pragma unroll
                for (int m = 0; m < 4; ++m)
#pragma unroll
                    for (int n = 0; n < 2; ++n) acc[a][b][m][n] = (f32x4){0.f, 0.f, 0.f, 0.f};
        cur = nxt; cA = nA; cB = nB; ++ui;
        if constexpr (ALIGN_EPI) { if (wr == 1) PG8_BAR; }
    }
    PG8_WAIT_V(0);
    if constexpr (!ALIGN_EPI) { if (wr == 0) PG8_BAR; }
    PG8_BAR;
    if constexpr (Epi::AFTER_DRAIN) { E.fused(acc, cur, wr, wc, fr, fq, lds, wid, lane); S.done(cur); }
#undef PG8_SA
#undef PG8_SB
#undef PG8_STAGE
#undef PG8_LDA
#undef PG8_LDB
#undef PG8_MMA
#undef PG8_WAIT_V
#undef PG8_WAIT_L
#undef PG8_BAR
#undef PG8_SCHED
}
}
constexpr int NWAVES = 8;
constexpr int MP = 16384, MS = 1024, MT = MP + MS;
constexpr int D = 1024, FF = 2816, NIN = 1792, DPLE = 256, SEQ = 2048, PAST = 16384;
constexpr int ROPE_ROWS = 2048 + 8;
constexpr size_t OUT_Y = 0, OUT_PKW = 17825792, OUT_PVW = 17956864, OUT_PCV = 18087936, OUT_SKW = 18612224, OUT_SVW = 20709376, OUT_SCV = 22806528, OUT_END = 23330816;
constexpr size_t WS_W1T = 0, WS_W1D = WS_W1T + 11534336, WS_WIN = WS_W1D + 5767168, WS_WO = WS_WIN + 3670016, WS_W2T = WS_WO + 2097152, WS_W2D = WS_W2T + 11534336,
                 WS_WPG = WS_W2D + 5767168, WS_WPP = WS_WPG + 2097152, WS_R = WS_WPP + 524288;
constexpr size_t WS_ACT = WS_R, WS_Z = WS_R, WS_MIX = WS_R + (size_t)MT * NIN * 2;
constexpr size_t WS_PRJ = WS_R + (size_t)MT * FF * 2, WS_XB = WS_PRJ + (size_t)MT * D * 2, WS_SS = WS_XB + (size_t)MT * D * 2, WS_PE = WS_SS + (size_t)MT * 16 * 4,
                 WS_ROPE = WS_PE + (size_t)MT * DPLE * 2, WS_END = WS_ROPE + (size_t)ROPE_ROWS * 32 * 8;
constexpr int XCD_BAR_WORDS_C = 3456;
constexpr size_t WS_CTL = WS_END, CTL_BYTES = 16384;
static_assert(WS_MIX + (size_t)MT * D * 2 <= WS_PRJ && WS_CTL % 256 == 0 && WS_CTL + CTL_BYTES <= 268435456 && XCD_BAR_WORDS_C * 4 <= CTL_BYTES, "d_ws map");
constexpr int LDS_BYTES = 155648, OFF_MISC = LDS_BYTES - 256;

#define LAS __attribute__((address_space(3)))
typedef unsigned short bf16;
typedef unsigned v4u __attribute__((ext_vector_type(4)));
typedef unsigned v2u __attribute__((ext_vector_type(2)));
typedef float f32x4 __attribute__((ext_vector_type(4)));
typedef float f32x2 __attribute__((ext_vector_type(2)));
typedef short bf16x8 __attribute__((ext_vector_type(8)));
using pg8::cvt_pk_bf16;

struct Args {
    const float* in[29]; float* out; unsigned char* ws; int ph_lo, ph_hi;
};

struct Frame {
    LAS unsigned char* lds; int tid, lane, wave, G;
    const __attribute__((address_space(4))) Args* a; float* out;
    bf16 *Z, *MIX; const f32x2* rope;
};

__device__ __forceinline__ float wave_sum(float v) {
#pragma unroll
    for (int o = 1; o < 64; o <<= 1) v += __shfl_xor(v, o);
    return v;
}
__device__ __forceinline__ float bf2f(unsigned short h) { return __uint_as_float((unsigned)h << 16); }
__device__ __forceinline__ void unpack2(unsigned w, float& lo, float& hi) { lo = __uint_as_float(w << 16); hi = __uint_as_float(w & 0xffff0000u); }
__device__ __forceinline__ void unpack8(const v4u w, float* f) { unpack2(w.x, f[0], f[1]); unpack2(w.y, f[2], f[3]); unpack2(w.z, f[4], f[5]); unpack2(w.w, f[6], f[7]); }
__device__ __forceinline__ v4u pack8(const float* f) { v4u w; w.x = cvt_pk_bf16(f[0], f[1]); w.y = cvt_pk_bf16(f[2], f[3]); w.z = cvt_pk_bf16(f[4], f[5]); w.w = cvt_pk_bf16(f[6], f[7]); return w; }
__device__ __forceinline__ bf16x8 as_bf16x8(const v4u w) { return __builtin_bit_cast(bf16x8, w); }
__device__ __forceinline__ float gelu_tanh(float x) {
    const float u = 1.5957691216057308f * x * (1.0f + 0.044715f * x * x);
    return x * __builtin_amdgcn_rcpf(1.0f + __expf(-u));
}

struct TItem { const float* W; const float* gk; bf16* WT; int K, N, mode, item; };
struct TRegs { f32x4 v[8]; };
__device__ __forceinline__ TRegs t_load(const TItem& t, int lane) {
    const int nblk = t.N / 32, kb = t.item / nblk, nb = t.item % nblk, k0 = 64 * kb, n0 = 32 * nb; TRegs r;
    const float* p = t.W + (size_t)(k0 + (lane >> 3)) * t.N + n0 + 4 * (lane & 7);
#pragma unroll
    for (int i = 0; i < 8; ++i) r.v[i] = *(const f32x4*)(p + (size_t)(8 * i) * t.N);
    if (t.gk) {
#pragma unroll
        for (int i = 0; i < 8; ++i) r.v[i] = r.v[i] * t.gk[k0 + (lane >> 3) + 8 * i];
    }
    return r;
}
__device__ __forceinline__ void t_store(const TItem& t, const TRegs& r, LAS float* scr, int lane) {
    const int nblk = t.N / 32, kb = t.item / nblk, nb = t.item % nblk, k0 = 64 * kb, n0 = 32 * nb;
    const int rbase = (t.mode == 0) ? n0 : (((n0 >> 7) << 8) + (n0 & 127) + (t.mode == 2 ? 128 : 0));
#pragma unroll
    for (int i = 0; i < 8; ++i) { LAS float* d = scr + ((lane >> 3) + 8 * i) * 33 + 4 * (lane & 7); d[0] = r.v[i][0]; d[1] = r.v[i][1]; d[2] = r.v[i][2]; d[3] = r.v[i][3]; }
    asm volatile("s_waitcnt lgkmcnt(0)" ::: "memory");
    const int c = lane & 7;
#pragma unroll
    for (int j = 0; j < 4; ++j) { const int n = (lane >> 3) + 8 * j; const LAS float* s = scr + (8 * c) * 33 + n;
        v4u o; o.x = cvt_pk_bf16(s[0 * 33], s[1 * 33]); o.y = cvt_pk_bf16(s[2 * 33], s[3 * 33]); o.z = cvt_pk_bf16(s[4 * 33], s[5 * 33]); o.w = cvt_pk_bf16(s[6 * 33], s[7 * 33]);
        *(v4u*)(t.WT + (size_t)(rbase + n) * t.K + k0 + 8 * c) = o; }
    asm volatile("s_waitcnt lgkmcnt(0)" ::: "memory");
}
__device__ __forceinline__ TItem t_decode(Frame& F, int it) {
    const __attribute__((address_space(4))) Args& A = *F.a; unsigned char* ws = A.ws;
    constexpr int I_FU = (D / 64) * (FF / 32), I_IN = (D / 64) * (NIN / 32), I_SQ = (D / 64) * (D / 32);
    TItem t; int r = it;
    if (r < I_FU) { t = TItem{A.in[7], A.in[6], (bf16*)(ws + WS_W1T), D, FF, 1, r}; return t; } r -= I_FU;
    if (r < I_FU) { t = TItem{A.in[8], A.in[6], (bf16*)(ws + WS_W1T), D, FF, 2, r}; return t; } r -= I_FU;
    if (r < I_FU) { t = TItem{A.in[9], nullptr, (bf16*)(ws + WS_W1D), FF, D, 0, r}; return t; } r -= I_FU;
    if (r < I_FU) { t = TItem{A.in[23], A.in[22], (bf16*)(ws + WS_W2T), D, FF, 1, r}; return t; } r -= I_FU;
    if (r < I_FU) { t = TItem{A.in[24], A.in[22], (bf16*)(ws + WS_W2T), D, FF, 2, r}; return t; } r -= I_FU;
    if (r < I_FU) { t = TItem{A.in[25], nullptr, (bf16*)(ws + WS_W2D), FF, D, 0, r}; return t; } r -= I_FU;
    if (r < I_IN) { t = TItem{A.in[11], A.in[10], (bf16*)(ws + WS_WIN), D, NIN, 0, r}; return t; } r -= I_IN;
    if (r < I_SQ) { t = TItem{A.in[21], nullptr, (bf16*)(ws + WS_WO), D, D, 0, r}; return t; } r -= I_SQ;
    if (r < I_SQ) { t = TItem{A.in[27], A.in[26], (bf16*)(ws + WS_WPG), D, D, 0, r}; return t; } r -= I_SQ;
    t = TItem{A.in[28], nullptr, (bf16*)(ws + WS_WPP), DPLE, D, 0, r}; return t;
}
__device__ __forceinline__ void p0_prologue(Frame& F) {
    const __attribute__((address_space(4))) Args& A = *F.a; unsigned char* ws = A.ws;
    LAS float* scr = (LAS float*)(F.lds + F.wave * 16384);
    const int gw = blockIdx.x * NWAVES + F.wave, NGW = F.G * NWAVES;
    constexpr int I_FU = (D / 64) * (FF / 32), I_FD = (FF / 64) * (D / 32), I_IN = (D / 64) * (NIN / 32), I_SQ = (D / 64) * (D / 32), I_PP = (DPLE / 64) * (D / 32);
    constexpr int NITEMS = 6 * I_FU + I_IN + 2 * I_SQ + I_PP;
    static_assert(I_FU == I_FD, "");
    {
        TItem t0 = t_decode(F, gw < NITEMS ? gw : 0), t1 = t_decode(F, gw + NGW < NITEMS ? gw + NGW : 0);
        TRegs r0 = t_load(t0, F.lane), r1 = t_load(t1, F.lane);
#pragma unroll 1
        for (int it = gw; it < NITEMS; it += 2 * NGW) {
            const int n0 = it + 2 * NGW, n1 = it + 3 * NGW;
            const TItem u0 = t_decode(F, n0 < NITEMS ? n0 : 0), u1 = t_decode(F, n1 < NITEMS ? n1 : 0);
            const TRegs q0 = t_load(u0, F.lane), q1 = t_load(u1, F.lane);
            t_store(t0, r0, scr, F.lane);
            if (it + NGW < NITEMS) t_store(t1, r1, scr, F.lane);
            t0 = u0; t1 = u1; r0 = q0; r1 = q1;
        }
    }
    bf16* XB = (bf16*)(ws + WS_XB); float* SS = (float*)(ws + WS_SS); bf16* PE = (bf16*)(ws + WS_PE);
#pragma unroll 1
    for (int m0 = gw; m0 < MT; m0 += 2 * NGW) {
        f32x4 v[2][4], pv[2]; int mm[2];
#pragma unroll
        for (int q = 0; q < 2; ++q) {
            const int m = (m0 + q * NGW < MT) ? m0 + q * NGW : m0; mm[q] = m;
            const float* xrow = (m < MP) ? A.in[0] + (size_t)m * D : A.in[1] + (size_t)(m - MP) * D;
            const float* prow = (m < MP) ? A.in[2] + (size_t)m * DPLE : A.in[3] + (size_t)(m - MP) * DPLE;
#pragma unroll
            for (int j = 0; j < 4; ++j) v[q][j] = *((const f32x4*)xrow + F.lane + 64 * j);
            pv[q] = *((const f32x4*)prow + F.lane);
        }
#pragma unroll
        for (int q = 0; q < 2; ++q) {
            const int m = mm[q]; float s = 0.f;
#pragma unroll
            for (int j = 0; j < 4; ++j) s += (v[q][j][0] * v[q][j][0] + v[q][j][1] * v[q][j][1]) + (v[q][j][2] * v[q][j][2] + v[q][j][3] * v[q][j][3]);
            s = wave_sum(s);
            v2u* o8 = (v2u*)(XB + (size_t)m * D) + F.lane;
#pragma unroll
            for (int j = 0; j < 4; ++j) { v2u w; w.x = cvt_pk_bf16(v[q][j][0], v[q][j][1]); w.y = cvt_pk_bf16(v[q][j][2], v[q][j][3]); o8[64 * j] = w; }
            if (F.lane < 16) SS[(size_t)m * 16 + F.lane] = (F.lane == 0) ? s : 0.f;
            v2u w; w.x = cvt_pk_bf16(pv[q][0], pv[q][1]); w.y = cvt_pk_bf16(pv[q][2], pv[q][3]);
            *((v2u*)(PE + (size_t)m * DPLE) + F.lane) = w;
        }
    }
    f32x2* rope = (f32x2*)(ws + WS_ROPE);
    for (int e = blockIdx.x * (NWAVES * 64) + F.tid; e < ROPE_ROWS * 32; e += F.G * NWAVES * 64) {
        const int pr = e >> 5, i = e & 31; const int pos = pr < 2048 ? pr : PAST + (pr - 2048);
        const double inv = (double)exp2f(-(float)i * (13.287712379549449f / 32.0f));
        double t = (double)pos * inv * 0.15915494309189535; t -= floor(t);
        const float f = (float)t;
        rope[e] = (f32x2){__builtin_amdgcn_cosf(f), __builtin_amdgcn_sinf(f)};
    }
}

constexpr int VT_A = 136;
constexpr int KP = 72, VP = 264;
constexpr int LDS_PART = 141312 + 4096 - 4096;
constexpr int OFF_PART = 141312, OFF_RED = OFF_PART + 4096, OFF_STAT = OFF_RED + 1024;
static_assert(512 * VT_A * 2 <= OFF_PART && 2 * 256 * KP * 2 + 2 * 64 * VP * 2 <= OFF_PART && OFF_STAT + 1024 <= OFF_MISC, "mixer LDS map");

template <int PW>
__device__ __forceinline__ void finalize_rows(Frame& F, size_t m0, int coloff, const float* g) {
    const LAS float* part = (const LAS float*)(F.lds + OFF_PART);
    float gv[8];
#pragma unroll
    for (int j = 0; j < 8; ++j) gv[j] = g[8 * F.lane + j];
    constexpr int BATCH = PW < 8 ? PW : 8;
#pragma unroll 1
    for (int i0 = 0; i0 < PW; i0 += BATCH) {
        v4u raw[BATCH];
#pragma unroll
        for (int i = 0; i < BATCH; ++i) raw[i] = *(const v4u*)(F.MIX + (m0 + F.wave * PW + i0 + i) * D + coloff + 8 * F.lane);
#pragma unroll
        for (int i = 0; i < BATCH; ++i) {
            const int tt = F.wave * PW + i0 + i;
            const f32x4 p0 = *(const LAS f32x4*)(part + tt * 8), p1 = *(const LAS f32x4*)(part + tt * 8 + 4);
            const float tot = ((p0[0] + p0[1]) + (p0[2] + p0[3])) + ((p1[0] + p1[1]) + (p1[2] + p1[3]));
            const float rs = __builtin_amdgcn_rsqf(tot * (1.0f / 512.0f) + 1e-6f);
            float x[8]; unpack8(raw[i], x);
#pragma unroll
            for (int j = 0; j < 8; ++j) x[j] = x[j] * rs * gv[j];
            *(v4u*)(F.MIX + (m0 + tt) * D + coloff + 8 * F.lane) = pack8(x);
        }
    }
}

__device__ __forceinline__ void mix_prompt_A(Frame& F, int n, int c) {
    const __attribute__((address_space(4))) Args& A = *F.a;
    LAS bf16* Vt = (LAS bf16*)F.lds; LAS float* part = (LAS float*)(F.lds + OFF_PART); LAS float* stat = (LAS float*)(F.lds + OFF_STAT);
    const size_t m0 = (size_t)n * SEQ + (size_t)c * 128; const int lane = F.lane, w = F.wave, tid = F.tid;
#pragma unroll 1
    for (int i0 = 0; i0 < 16; i0 += 8) {
        v4u raw[8];
#pragma unroll
        for (int i = 0; i < 8; ++i) raw[i] = *(const v4u*)(F.Z + (m0 + w * 16 + i0 + i) * NIN + 512 + 8 * lane);
        float sm[8], sq[8];
#pragma unroll
        for (int i = 0; i < 8; ++i) { float x[8]; unpack8(raw[i], x); float a = 0.f, b = 0.f;
#pragma unroll
            for (int j = 0; j < 8; ++j) { a += x[j]; b += x[j] * x[j]; }
            sm[i] = a; sq[i] = b; }
#pragma unroll
        for (int o = 1; o < 64; o <<= 1) {
#pragma unroll
            for (int i = 0; i < 8; ++i) { sm[i] += __shfl_xor(sm[i], o); sq[i] += __shfl_xor(sq[i], o); } }
        if (lane == 0) {
#pragma unroll
            for (int i = 0; i < 8; ++i) { const float mean = sm[i] * (1.0f / 512.0f), var = fmaxf(sq[i] * (1.0f / 512.0f) - mean * mean, 0.f);
                stat[2 * (w * 16 + i0 + i)] = mean; stat[2 * (w * 16 + i0 + i) + 1] = __builtin_amdgcn_rsqf(var + 1e-6f); }
        }
    }
    __syncthreads();
    {
        const int col = tid; const float gc = A.in[12][col], bc = A.in[13][col];
        const bf16* zc = F.Z + m0 * NIN + 512 + col;
        float* cv = F.out + OUT_PCV + ((size_t)n * 128) * 512 + col;
#pragma unroll 1
        for (int g32 = 0; g32 < 4; ++g32) {
            unsigned short hv[32];
#pragma unroll
            for (int j = 0; j < 32; ++j) hv[j] = zc[(size_t)(32 * g32 + j) * NIN];
#pragma unroll
            for (int q = 0; q < 4; ++q) {
                float y[8];
#pragma unroll
                for (int j = 0; j < 8; ++j) { const int tt = 32 * g32 + 8 * q + j; const f32x2 st = *(const LAS f32x2*)(stat + 2 * tt); y[j] = (bf2f(hv[8 * q + j]) - st.x) * st.y * gc + bc; }
                if (c == 15) {
#pragma unroll
                    for (int j = 0; j < 8; ++j) cv[(size_t)(32 * g32 + 8 * q + j) * 512] = y[j];
                }
                *(LAS v4u*)(Vt + col * VT_A + 32 * g32 + 8 * q) = pack8(y);
            }
        }
    }
    __syncthreads();
    {
        const int h = w, fr = lane & 15, fq = lane >> 4;
        const float* wbase = A.in[14] + (size_t)h * 128 * 128 + 8 * fq; const float* bsb = A.in[15] + h * 128;
#pragma unroll
        for (int half = 0; half < 4; ++half) {
            f32x4 wa[2][4], wb[2][4]; v2u ur[2][4]; float bias[2];
#pragma unroll
            for (int q = 0; q < 2; ++q) {
                const int tb = 2 * half + q, t = tb * 16 + fr, nks = tb / 2 + 1;
#pragma unroll
                for (int ks = 0; ks < 4; ++ks) if (ks < nks) { const float* wp = wbase + (size_t)t * 128 + 32 * ks; wa[q][ks] = *(const f32x4*)wp; wb[q][ks] = *(const f32x4*)(wp + 4); }
#pragma unroll
                for (int db = 0; db < 4; ++db) ur[q][db] = *(const v2u*)(F.Z + (m0 + t) * NIN + 64 * h + 16 * db + 4 * fq);
                bias[q] = bsb[t];
            }
#pragma unroll
            for (int q = 0; q < 2; ++q) {
                const int tb = 2 * half + q, t = tb * 16 + fr, nks = tb / 2 + 1;
                bf16x8 Y[4];
#pragma unroll
                for (int ks = 0; ks < 4; ++ks) if (ks < nks) {
                    const int s0 = 32 * ks + 8 * fq; float f[8];
#pragma unroll
                    for (int j = 0; j < 4; ++j) { f[j] = (s0 + j <= t) ? wa[q][ks][j] : 0.f; f[4 + j] = (s0 + 4 + j <= t) ? wb[q][ks][j] : 0.f; }
                    Y[ks] = as_bf16x8(pack8(f));
                }
                float ssq = 0.f;
#pragma unroll
                for (int db = 0; db < 4; ++db) {
                    f32x4 acc = {0.f, 0.f, 0.f, 0.f};
#pragma unroll
                    for (int ks = 0; ks < 4; ++ks) if (ks < nks) {
                        const bf16x8 X = *(const LAS bf16x8*)(Vt + (64 * h + 16 * db + fr) * VT_A + 32 * ks + 8 * fq);
                        acc = __builtin_amdgcn_mfma_f32_16x16x32_bf16(X, Y[ks], acc, 0, 0, 0);
                    }
                    float u0, u1, u2, u3; unpack2(ur[q][db].x, u0, u1); unpack2(ur[q][db].y, u2, u3);
                    const float a0 = u0 * (acc[0] + bias[q]), a1 = u1 * (acc[1] + bias[q]), a2 = u2 * (acc[2] + bias[q]), a3 = u3 * (acc[3] + bias[q]);
                    ssq += (a0 * a0 + a1 * a1) + (a2 * a2 + a3 * a3);
                    v2u o; o.x = cvt_pk_bf16(a0, a1); o.y = cvt_pk_bf16(a2, a3);
                    *(v2u*)(F.MIX + (m0 + t) * D + 64 * h + 16 * db + 4 * fq) = o;
                }
                ssq += __shfl_xor(ssq, 16); ssq += __shfl_xor(ssq, 32);
                if (fq == 0) part[t * 8 + h] = ssq;
            }
        }
    }
    __syncthreads();
    finalize_rows<16>(F, m0, 0, A.in[19]);
}

__device__ __forceinline__ void k_norm_rope(Frame& F, const bf16* zk, int prow, LAS bf16* krow, float* kout) {
    const __attribute__((address_space(4))) Args& A = *F.a; const float* gk = A.in[17];
    float ss = 0.f;
#pragma unroll
    for (int i = 0; i < 8; ++i) { float x[8]; unpack8(*(const v4u*)(zk + 8 * i), x);
#pragma unroll
        for (int j = 0; j < 8; ++j) ss += x[j] * x[j]; }
    const float rs = __builtin_amdgcn_rsqf(ss * (1.0f / 64.0f) + 1e-6f);
    const f32x2* tab = F.rope + prow * 32;
#pragma unroll 1
    for (int i = 0; i < 4; ++i) {
        float x1[8], x2[8], o1[8], o2[8]; unpack8(*(const v4u*)(zk + 8 * i), x1); unpack8(*(const v4u*)(zk + 32 + 8 * i), x2);
#pragma unroll
        for (int j = 0; j < 8; ++j) { const float a = x1[j] * rs * gk[8 * i + j], b = x2[j] * rs * gk[32 + 8 * i + j]; const f32x2 cs = tab[8 * i + j]; o1[j] = a * cs.x - b * cs.y; o2[j] = b * cs.x + a * cs.y; }
        *(LAS v4u*)(krow + 8 * i) = pack8(o1); *(LAS v4u*)(krow + 32 + 8 * i) = pack8(o2);
        if (kout) {
            *(f32x4*)(kout + 8 * i) = (f32x4){o1[0], o1[1], o1[2], o1[3]}; *(f32x4*)(kout + 8 * i + 4) = (f32x4){o1[4], o1[5], o1[6], o1[7]};
            *(f32x4*)(kout + 32 + 8 * i) = (f32x4){o2[0], o2[1], o2[2], o2[3]}; *(f32x4*)(kout + 32 + 8 * i + 4) = (f32x4){o2[4], o2[5], o2[6], o2[7]};
        }
        asm volatile("" ::: "memory");
    }
}
__device__ __forceinline__ void v_fill(const bf16* zv, LAS bf16* vcol  , float* vout) {
#pragma unroll 1
    for (int i = 0; i < 8; ++i) {
        const v4u raw = *(const v4u*)(zv + 8 * i); float x[8]; unpack8(raw, x);
#pragma unroll
        for (int j = 0; j < 8; ++j) vcol[(8 * i + j) * VP] = (bf16)(__float_as_uint(x[j]) >> 16);
        if (vout) { *(f32x4*)(vout + 8 * i) = (f32x4){x[0], x[1], x[2], x[3]}; *(f32x4*)(vout + 8 * i + 4) = (f32x4){x[4], x[5], x[6], x[7]}; }
        asm volatile("" ::: "memory");
    }
}

__device__ __forceinline__ void kv_fill(Frame& F, const bf16* zk, const bf16* zv, int prow, LAS bf16* krow, LAS bf16* vcol, float* kout, float* vout) {
    const Args __attribute__((address_space(4)))& A = *F.a; const float* gk = A.in[17];
    v4u rk[8], rv[8];
#pragma unroll
    for (int i = 0; i < 8; ++i) { rk[i] = *(const v4u*)(zk + 8 * i); rv[i] = *(const v4u*)(zv + 8 * i); }
    float ss = 0.f;
#pragma unroll
    for (int i = 0; i < 8; ++i) { float x[8]; unpack8(rk[i], x);
#pragma unroll
        for (int j = 0; j < 8; ++j) ss += x[j] * x[j]; }
    const float rs = __builtin_amdgcn_rsqf(ss * (1.0f / 64.0f) + 1e-6f);
    const f32x4* tab = (const f32x4*)(F.rope + prow * 32);
#pragma unroll
    for (int i = 0; i < 4; ++i) {
        float x1[8], x2[8], o1[8], o2[8]; unpack8(rk[i], x1); unpack8(rk[4 + i], x2);
        const f32x4 t0 = tab[4 * i], t1 = tab[4 * i + 1], t2 = tab[4 * i + 2], t3 = tab[4 * i + 3];
        const float cs[16] = {t0[0], t0[1], t0[2], t0[3], t1[0], t1[1], t1[2], t1[3], t2[0], t2[1], t2[2], t2[3], t3[0], t3[1], t3[2], t3[3]};
        const f32x4 ga = *(const f32x4*)(gk + 8 * i), gb = *(const f32x4*)(gk + 8 * i + 4), gc = *(const f32x4*)(gk + 32 + 8 * i), gd = *(const f32x4*)(gk + 32 + 8 * i + 4);
        const float g1[8] = {ga[0], ga[1], ga[2], ga[3], gb[0], gb[1], gb[2], gb[3]}, g2[8] = {gc[0], gc[1], gc[2], gc[3], gd[0], gd[1], gd[2], gd[3]};
#pragma unroll
        for (int j = 0; j < 8; ++j) { const float a = x1[j] * rs * g1[j], b = x2[j] * rs * g2[j]; o1[j] = a * cs[2 * j] - b * cs[2 * j + 1]; o2[j] = b * cs[2 * j] + a * cs[2 * j + 1]; }
        *(LAS v4u*)(krow + 8 * i) = pack8(o1); *(LAS v4u*)(krow + 32 + 8 * i) = pack8(o2);
        if (kout) {
            *(f32x4*)(kout + 8 * i) = (f32x4){o1[0], o1[1], o1[2], o1[3]}; *(f32x4*)(kout + 8 * i + 4) = (f32x4){o1[4], o1[5], o1[6], o1[7]};
            *(f32x4*)(kout + 32 + 8 * i) = (f32x4){o2[0], o2[1], o2[2], o2[3]}; *(f32x4*)(kout + 32 + 8 * i + 4) = (f32x4){o2[4], o2[5], o2[6], o2[7]};
        }
        asm volatile("" ::: "memory");
    }
#pragma unroll
    for (int i = 0; i < 8; ++i) {
        const unsigned wv[4] = {rv[i].x, rv[i].y, rv[i].z, rv[i].w};
#pragma unroll
        for (int q = 0; q < 4; ++q) { vcol[(8 * i + 2 * q) * VP] = (bf16)(wv[q] & 0xffffu); vcol[(8 * i + 2 * q + 1) * VP] = (bf16)(wv[q] >> 16); }
        if (vout) { float x[8]; unpack8(rv[i], x); *(f32x4*)(vout + 8 * i) = (f32x4){x[0], x[1], x[2], x[3]}; *(f32x4*)(vout + 8 * i + 4) = (f32x4){x[4], x[5], x[6], x[7]}; }
    }
}

struct QRaw { v4u q0, q1; f32x4 t[4]; };
__device__ __forceinline__ QRaw q_load(Frame& F, size_t mrow, int hq, int prow) {
    const int fq = F.lane >> 4; QRaw r;
    const bf16* zq = F.Z + mrow * NIN + 1024 + 64 * hq + 8 * fq;
    r.q0 = *(const v4u*)zq; r.q1 = *(const v4u*)(zq + 32);
    const f32x4* tab = (const f32x4*)(F.rope + prow * 32 + 8 * fq);
#pragma unroll
    for (int i = 0; i < 4; ++i) r.t[i] = tab[i];
    return r;
}
__device__ __forceinline__ void attn_qblock(Frame& F, const QRaw& qr, const float (&gq1)[8], const float (&gq2)[8], const LAS bf16* Kl, const LAS bf16* Vl, LAS float* partp, size_t mrow, int tq, int tq_lo, int tq_hi, int hq, float sink_nat, int kb0, int jmin) {
    const int fq = F.lane >> 4;
    float x1[8], x2[8]; unpack8(qr.q0, x1); unpack8(qr.q1, x2);
    float ss = 0.f;
#pragma unroll
    for (int j = 0; j < 8; ++j) ss += x1[j] * x1[j] + x2[j] * x2[j];
    ss += __shfl_xor(ss, 16); ss += __shfl_xor(ss, 32);
    const float rs = (0.125f * 1.4426950408889634f) * __builtin_amdgcn_rsqf(ss * (1.0f / 64.0f) + 1e-6f);
#pragma unroll
    for (int j = 0; j < 8; ++j) { const float a = x1[j] * rs * gq1[j], b = x2[j] * rs * gq2[j]; const float cc = qr.t[j >> 1][2 * (j & 1)], sn = qr.t[j >> 1][2 * (j & 1) + 1]; x1[j] = a * cc - b * sn; x2[j] = b * cc + a * sn; }
    const bf16x8 Yq0 = as_bf16x8(pack8(x1)), Yq1 = as_bf16x8(pack8(x2));
    f32x4 S[10];
#pragma unroll
    for (int kk = 0; kk < 10; ++kk) {
        const LAS bf16* kp = Kl + (16 * (kb0 + kk) + (F.lane & 15)) * KP + 8 * fq;
        const bf16x8 X0 = *(const LAS bf16x8*)kp, X1 = *(const LAS bf16x8*)(kp + 32);
        f32x4 a = {0.f, 0.f, 0.f, 0.f};
        a = __builtin_amdgcn_mfma_f32_16x16x32_bf16(X0, Yq0, a, 0, 0, 0);
        a = __builtin_amdgcn_mfma_f32_16x16x32_bf16(X1, Yq1, a, 0, 0, 0);
        S[kk] = a;
    }
    const float sink = sink_nat * 1.4426950408889634f;
    float mx = sink;
#pragma unroll
    for (int kk = 0; kk < 10; ++kk) {
        const int jb = 16 * (kb0 + kk);
        if (jb > tq_hi && jb + 15 <= tq_lo + 128 && jb >= jmin) {
#pragma unroll
            for (int v = 0; v < 4; ++v) mx = fmaxf(mx, S[kk][v]);
        } else {
#pragma unroll
            for (int v = 0; v < 4; ++v) { const int j = jb + 4 * fq + v; const bool ok = (j > tq) && (j <= tq + 128) && (j >= jmin); S[kk][v] = ok ? S[kk][v] : -INFINITY; mx = fmaxf(mx, S[kk][v]); }
        }
    }
    mx = fmaxf(mx, __shfl_xor(mx, 16)); mx = fmaxf(mx, __shfl_xor(mx, 32));
    float sum = 0.f;
#pragma unroll
    for (int kk = 0; kk < 10; ++kk)
#pragma unroll
        for (int v = 0; v < 4; ++v) { const float p = __builtin_amdgcn_exp2f(S[kk][v] - mx); S[kk][v] = p; sum += p; }
    sum += __shfl_xor(sum, 16); sum += __shfl_xor(sum, 32);
    const float inv = __builtin_amdgcn_rcpf(sum + __builtin_amdgcn_exp2f(sink - mx));
    bf16x8 Yp[5];
#pragma unroll
    for (int i = 0; i < 5; ++i) { v4u w; w.x = cvt_pk_bf16(S[2 * i][0], S[2 * i][1]); w.y = cvt_pk_bf16(S[2 * i][2], S[2 * i][3]); w.z = cvt_pk_bf16(S[2 * i + 1][0], S[2 * i + 1][1]); w.w = cvt_pk_bf16(S[2 * i + 1][2], S[2 * i + 1][3]); Yp[i] = as_bf16x8(w); }
    float ssq = 0.f;
#pragma unroll
    for (int db = 0; db < 4; ++db) {
        f32x4 o = {0.f, 0.f, 0.f, 0.f};
#pragma unroll
        for (int i = 0; i < 5; ++i) {
            const LAS bf16* vp = Vl + (16 * db + (F.lane & 15)) * VP + 16 * (kb0 + 2 * i) + 4 * fq;
            const v2u lo = *(const LAS v2u*)vp, hi = *(const LAS v2u*)(vp + 16);
            v4u xw; xw.x = lo.x; xw.y = lo.y; xw.z = hi.x; xw.w = hi.y;
            o = __builtin_amdgcn_mfma_f32_16x16x32_bf16(as_bf16x8(xw), Yp[i], o, 0, 0, 0);
        }
        o = o * inv; ssq += (o[0] * o[0] + o[1] * o[1]) + (o[2] * o[2] + o[3] * o[3]);
        v2u ow; ow.x = cvt_pk_bf16(o[0], o[1]); ow.y = cvt_pk_bf16(o[2], o[3]);
        *(v2u*)(F.MIX + mrow * D + 512 + 64 * hq + 16 * db + 4 * fq) = ow;
    }
    ssq += __shfl_xor(ssq, 16); ssq += __shfl_xor(ssq, 32);
    if (fq == 0) *partp = ssq;
}

__device__ __forceinline__ void mix_prompt_B(Frame& F, int n, int c) {
    const __attribute__((address_space(4))) Args& A = *F.a;
    LAS bf16* Kl = (LAS bf16*)F.lds; LAS bf16* Vl = (LAS bf16*)(F.lds + 2 * 256 * KP * 2); LAS float* part = (LAS float*)(F.lds + OFF_PART);
    const size_t m0 = (size_t)n * SEQ + (size_t)c * 128; const int lane = F.lane, w = F.wave, tid = F.tid;
    {
        const int kv = tid >> 8, j = tid & 255;
        LAS bf16* krow = Kl + (kv * 256 + j) * KP; LAS bf16* vcol = Vl + kv * 64 * VP + j;
        if (c == 0 && j < 128) {
#pragma unroll
            for (int i = 0; i < 8; ++i) *(LAS v4u*)(krow + 8 * i) = (v4u){0u, 0u, 0u, 0u};
            for (int d = 0; d < 64; ++d) vcol[d * VP] = 0;
        } else {
            const size_t mk = m0 - 128 + j; const bool tail = (c == 15 && j >= 128);
            float* kout = tail ? F.out + OUT_PKW + (((size_t)n * 128 + (j - 128)) * 2 + kv) * 64 : nullptr;
            float* vout = tail ? F.out + OUT_PVW + (((size_t)n * 128 + (j - 128)) * 2 + kv) * 64 : nullptr;
            kv_fill(F, F.Z + mk * NIN + 1536 + 64 * kv, F.Z + mk * NIN + 1664 + 64 * kv, (c - 1) * 128 + j, krow, vcol, kout, vout);
        }
    }
    __syncthreads();
    {
        const int h = w, kv = h >> 2, fr = lane & 15, fq = lane >> 4;
        float gq1[8], gq2[8];
#pragma unroll
        for (int j = 0; j < 8; ++j) { gq1[j] = A.in[16][8 * fq + j]; gq2[j] = A.in[16][32 + 8 * fq + j]; }
        const float sink = A.in[18][h];
        QRaw cur = q_load(F, m0 + fr, h, c * 128 + fr);
#pragma unroll 1
        for (int qb = 0; qb < 8; ++qb) {
            const int tq = 16 * qb + fr, tn = (qb < 7) ? tq + 16 : tq;
            const QRaw nxt = q_load(F, m0 + tn, h, c * 128 + tn);
            attn_qblock(F, cur, gq1, gq2, Kl + kv * 256 * KP, Vl + kv * 64 * VP, part + tq * 8 + h, m0 + tq, tq, 16 * qb, 16 * qb + 15, h, sink, qb & ~1, c == 0 ? 128 : 0);
            cur = nxt;
        }
    }
    __syncthreads();
    finalize_rows<16>(F, m0, 512, A.in[20]);
}

__device__ __forceinline__ void mix_sample_A(Frame& F, int n) {
    const __attribute__((address_space(4))) Args& A = *F.a;
    LAS float* red = (LAS float*)(F.lds + OFF_RED);
    const size_t m0 = (size_t)MP + (size_t)n * 8; const int lane = F.lane, w = F.wave, tid = F.tid;
    {
        const int col = tid, h = col >> 6;
        float v[8];
#pragma unroll
        for (int s = 0; s < 8; ++s) v[s] = bf2f(F.Z[(m0 + s) * NIN + 512 + col]);
#pragma unroll
        for (int s = 0; s < 8; ++s) { const float a = wave_sum(v[s]), b = wave_sum(v[s] * v[s]); if (lane == 0) { red[w * 16 + s] = a; red[w * 16 + 8 + s] = b; } }
        __syncthreads();
        const float gc = A.in[12][col], bc = A.in[13][col];
#pragma unroll
        for (int s = 0; s < 8; ++s) {
            float a = 0.f, b = 0.f;
#pragma unroll
            for (int ww = 0; ww < 8; ++ww) { a += red[ww * 16 + s]; b += red[ww * 16 + 8 + s]; }
            const float mean = a * (1.0f / 512.0f), var = fmaxf(b * (1.0f / 512.0f) - mean * mean, 0.f);
            v[s] = (v[s] - mean) * (__builtin_amdgcn_rsqf(var + 1e-6f)) * gc + bc;
            F.out[OUT_SCV + ((size_t)n * 8 + s) * 512 + col] = v[s];
        }
        __syncthreads();
        float a[8];
#pragma unroll
        for (int t = 0; t < 8; ++t) {
            const float* wr = A.in[14] + ((size_t)(h * 128 + t)) * 128; float mixed = A.in[15][h * 128 + t];
#pragma unroll
            for (int s = 0; s < 8; ++s) if (s <= t) mixed += wr[s] * v[s];
            a[t] = bf2f(F.Z[(m0 + t) * NIN + col]) * mixed;
            const float q = wave_sum(a[t] * a[t]); if (lane == 0) red[w * 16 + t] = q;
        }
        __syncthreads();
        const float go = A.in[19][col];
#pragma unroll
        for (int t = 0; t < 8; ++t) {
            float q = 0.f;
#pragma unroll
            for (int ww = 0; ww < 8; ++ww) q += red[ww * 16 + t];
            const float rs = __builtin_amdgcn_rsqf(q * (1.0f / 512.0f) + 1e-6f);
            F.MIX[(m0 + t) * D + col] = (bf16)(cvt_pk_bf16(a[t] * rs * go, 0.f) & 0xffffu);
        }
    }
}

__device__ __forceinline__ void mix_sample_B(Frame& F, int n) {
    const __attribute__((address_space(4))) Args& A = *F.a;
    LAS bf16* Kl = (LAS bf16*)F.lds; LAS bf16* Vl = (LAS bf16*)(F.lds + 2 * 256 * KP * 2); LAS float* part = (LAS float*)(F.lds + OFF_PART);
    const size_t m0 = (size_t)MP + (size_t)n * 8; const int lane = F.lane, w = F.wave, tid = F.tid;
    {
        const int kv = tid >> 8, j = tid & 255;
        LAS bf16* krow = Kl + (kv * 256 + j) * KP; LAS bf16* vcol = Vl + kv * 64 * VP + j;
        if (j < 128) {
            const float* ck = A.in[4] + (((size_t)n * 128 + j) * 2 + kv) * 64; const float* cvp = A.in[5] + (((size_t)n * 128 + j) * 2 + kv) * 64;
            float* ko = (j >= 8) ? F.out + OUT_SKW + (((size_t)n * 128 + (j - 8)) * 2 + kv) * 64 : nullptr;
            float* vo = (j >= 8) ? F.out + OUT_SVW + (((size_t)n * 128 + (j - 8)) * 2 + kv) * 64 : nullptr;
#pragma unroll 2
            for (int i = 0; i < 8; ++i) {
                const f32x4 k0 = __builtin_nontemporal_load((const f32x4*)(ck + 8 * i)), k1 = __builtin_nontemporal_load((const f32x4*)(ck + 8 * i + 4)), v0 = __builtin_nontemporal_load((const f32x4*)(cvp + 8 * i)), v1 = __builtin_nontemporal_load((const f32x4*)(cvp + 8 * i + 4));
                v4u kw; kw.x = cvt_pk_bf16(k0[0], k0[1]); kw.y = cvt_pk_bf16(k0[2], k0[3]); kw.z = cvt_pk_bf16(k1[0], k1[1]); kw.w = cvt_pk_bf16(k1[2], k1[3]);
                *(LAS v4u*)(krow + 8 * i) = kw;
                const unsigned va = cvt_pk_bf16(v0[0], v0[1]), vb = cvt_pk_bf16(v0[2], v0[3]), vc = cvt_pk_bf16(v1[0], v1[1]), vd = cvt_pk_bf16(v1[2], v1[3]);
                vcol[(8 * i + 0) * VP] = (bf16)(va & 0xffffu); vcol[(8 * i + 1) * VP] = (bf16)(va >> 16); vcol[(8 * i + 2) * VP] = (bf16)(vb & 0xffffu); vcol[(8 * i + 3) * VP] = (bf16)(vb >> 16);
                vcol[(8 * i + 4) * VP] = (bf16)(vc & 0xffffu); vcol[(8 * i + 5) * VP] = (bf16)(vc >> 16); vcol[(8 * i + 6) * VP] = (bf16)(vd & 0xffffu); vcol[(8 * i + 7) * VP] = (bf16)(vd >> 16);
                if (ko) { __builtin_nontemporal_store(k0, (f32x4*)(ko + 8 * i)); __builtin_nontemporal_store(k1, (f32x4*)(ko + 8 * i + 4)); __builtin_nontemporal_store(v0, (f32x4*)(vo + 8 * i)); __builtin_nontemporal_store(v1, (f32x4*)(vo + 8 * i + 4)); }
            }
        } else if (j >= 136 && j < 160) {
#pragma unroll
            for (int i = 0; i < 8; ++i) *(LAS v4u*)(krow + 8 * i) = (v4u){0u, 0u, 0u, 0u};
            for (int d = 0; d < 64; ++d) vcol[d * VP] = 0;
        }
    }
    if (w == 7) {
        const int task = lane >> 2, q = lane & 3, t = task & 7, kv2 = task >> 3; const size_t mk = m0 + t;
        const bf16* zk = F.Z + mk * NIN + 1536 + 64 * kv2 + 8 * q; const bf16* zv = F.Z + mk * NIN + 1664 + 64 * kv2 + 8 * q;
        const v4u k0 = *(const v4u*)zk, k1 = *(const v4u*)(zk + 32), v0 = *(const v4u*)zv, v1 = *(const v4u*)(zv + 32);
        const f32x4* tab = (const f32x4*)(F.rope + (2048 + t) * 32 + 8 * q); f32x4 tt[4];
#pragma unroll
        for (int i = 0; i < 4; ++i) tt[i] = tab[i];
        const float* gk = A.in[17]; float g1[8], g2[8];
#pragma unroll
        for (int j2 = 0; j2 < 8; ++j2) { g1[j2] = gk[8 * q + j2]; g2[j2] = gk[32 + 8 * q + j2]; }
        float x1[8], x2[8], o1[8], o2[8]; unpack8(k0, x1); unpack8(k1, x2);
        float ss = 0.f;
#pragma unroll
        for (int j2 = 0; j2 < 8; ++j2) ss += x1[j2] * x1[j2] + x2[j2] * x2[j2];
        ss += __shfl_xor(ss, 1); ss += __shfl_xor(ss, 2);
        const float rs = __builtin_amdgcn_rsqf(ss * (1.0f / 64.0f) + 1e-6f);
#pragma unroll
        for (int j2 = 0; j2 < 8; ++j2) { const float a = x1[j2] * rs * g1[j2], b = x2[j2] * rs * g2[j2]; const float cc = tt[j2 >> 1][2 * (j2 & 1)], sn = tt[j2 >> 1][2 * (j2 & 1) + 1]; o1[j2] = a * cc - b * sn; o2[j2] = b * cc + a * sn; }
        LAS bf16* krow = Kl + (kv2 * 256 + 128 + t) * KP;
        *(LAS v4u*)(krow + 8 * q) = pack8(o1); *(LAS v4u*)(krow + 32 + 8 * q) = pack8(o2);
        float* ko = F.out + OUT_SKW + (((size_t)n * 128 + (120 + t)) * 2 + kv2) * 64; float* vo = F.out + OUT_SVW + (((size_t)n * 128 + (120 + t)) * 2 + kv2) * 64;
        *(f32x4*)(ko + 8 * q) = (f32x4){o1[0], o1[1], o1[2], o1[3]}; *(f32x4*)(ko + 8 * q + 4) = (f32x4){o1[4], o1[5], o1[6], o1[7]};
        *(f32x4*)(ko + 32 + 8 * q) = (f32x4){o2[0], o2[1], o2[2], o2[3]}; *(f32x4*)(ko + 32 + 8 * q + 4) = (f32x4){o2[4], o2[5], o2[6], o2[7]};
        LAS bf16* vcol = Vl + kv2 * 64 * VP + 128 + t;
        float y1[8], y2[8]; unpack8(v0, y1); unpack8(v1, y2);
#pragma unroll
        for (int e = 0; e < 8; ++e) { vcol[(8 * q + e) * VP] = (bf16)(__float_as_uint(y1[e]) >> 16); vcol[(32 + 8 * q + e) * VP] = (bf16)(__float_as_uint(y2[e]) >> 16); }
        *(f32x4*)(vo + 8 * q) = (f32x4){y1[0], y1[1], y1[2], y1[3]}; *(f32x4*)(vo + 8 * q + 4) = (f32x4){y1[4], y1[5], y1[6], y1[7]};
        *(f32x4*)(vo + 32 + 8 * q) = (f32x4){y2[0], y2[1], y2[2], y2[3]}; *(f32x4*)(vo + 32 + 8 * q + 4) = (f32x4){y2[4], y2[5], y2[6], y2[7]};
    }
    __syncthreads();
    if (w < 4) {
        const int fr = lane & 15, fq = lane >> 4, hq = 2 * w + (fr >> 3), t = fr & 7, kv = w >> 1;
        float gq1[8], gq2[8];
#pragma unroll
        for (int j = 0; j < 8; ++j) { gq1[j] = A.in[16][8 * fq + j]; gq2[j] = A.in[16][32 + 8 * fq + j]; }
        const QRaw qr = q_load(F, m0 + t, hq, 2048 + t);
        attn_qblock(F, qr, gq1, gq2, Kl + kv * 256 * KP, Vl + kv * 64 * VP, part + t * 8 + hq, m0 + t, t, 0, 7, hq, A.in[18][hq], 0, 0);
    }
    __syncthreads();
    finalize_rows<1>(F, m0, 512, A.in[20]);
}

__device__ __forceinline__ void p4_mixer(Frame& F) {
    const int b = blockIdx.x, G = F.G;
#ifndef NO_A
    for (int it = b; it < 128; it += G) { __syncthreads(); mix_prompt_A(F, it >> 4, it & 15); }
#endif
    asm volatile("" ::: "memory");
#ifndef NO_B
    for (int it = b + ((128 - b + G * 64) / G) * 0; it < 256; it += G) { if (it >= 128) { __syncthreads(); mix_prompt_B(F, (it - 128) >> 4, (it - 128) & 15); } }
#endif
    asm volatile("" ::: "memory");
#ifndef NO_S
    for (int it = b; it < 128; it += G) { __syncthreads(); mix_sample_B(F, it); }
    asm volatile("" ::: "memory");
    for (int it = b; it < 256; it += G) { if (it >= 128) { __syncthreads(); mix_sample_A(F, it - 128); } }
#endif
}

#define XB_TMO      128
#define XB_XCNT(j)  (256  + 64 * (j))
#define XB_XSUB(j)  (1280 + 64 * (j))
#define XB_XGEN(j)  (2304 + 64 * (j))
#define XB_TOP      3328
#define XB_TOPGEN   3392
#define XCD_BAR_WORDS 3456
#define XB_SPIN_CAP (1u << 18)

__device__ __forceinline__ unsigned xb_ld(unsigned* p)              { return __hip_atomic_load(p, __ATOMIC_RELAXED, __HIP_MEMORY_SCOPE_AGENT); }
__device__ __forceinline__ unsigned xb_add(unsigned* p, unsigned v) { return __hip_atomic_fetch_add(p, v, __ATOMIC_RELAXED, __HIP_MEMORY_SCOPE_AGENT); }
__device__ __forceinline__ unsigned xb_xcc_id() { return (unsigned)__builtin_amdgcn_s_getreg((3 << 11) | 20) & 0xFu; }
#define XB_SPIN(cond, bar) do { unsigned _sp = 0; while (cond) { __builtin_amdgcn_s_sleep(1); \
    if ((++_sp & 255u) == 0u) { if (xb_ld(&(bar)[XB_TMO])) break; if (_sp > XB_SPIN_CAP) { atomicAdd(&(bar)[XB_TMO], 1u); break; } } } } while (0)

struct XcdBarrier {
    unsigned* bar; unsigned x;
    volatile LAS unsigned* st;
};

__device__ __forceinline__ XcdBarrier xcd_barrier_post(unsigned* bar, volatile LAS unsigned* st) {
    XcdBarrier b; b.bar = bar; b.x = xb_xcc_id(); b.st = st;
    if (threadIdx.x == 0) (void)xb_add(&bar[XB_XCNT(b.x)], 1u);
    return b;
}
__device__ __forceinline__ void xcd_barrier_complete(unsigned* bar, unsigned x, unsigned& nloc, unsigned& nx) {
    const unsigned G = gridDim.x * gridDim.y * gridDim.z;
    unsigned sum, cnt, mine, sp = 0u;
    for (;;) {
        sum = 0u; cnt = 0u; mine = 0u;
#pragma unroll
        for (unsigned j = 0; j < 16; ++j) { const unsigned c = xb_ld(&bar[XB_XCNT(j)]); sum += c; cnt += (c > 0u) ? 1u : 0u; mine = (j == x) ? c : mine; }
        if (sum == G) break;
        __builtin_amdgcn_s_sleep(1);
        if ((++sp & 255u) == 0u) { if (xb_ld(&bar[XB_TMO])) break; if (sp > XB_SPIN_CAP) { atomicAdd(&bar[XB_TMO], 1u); break; } }
    }
    nloc = mine > 0u ? mine : 1u; nx = cnt > 0u ? cnt : 1u;
}

__device__ __forceinline__ void xcd_barrier(const XcdBarrier& b) {
    asm volatile("s_waitcnt vmcnt(0)" ::: "memory");
    __syncthreads();
    if (threadIdx.x == 0) {
        unsigned* bar = b.bar;
        __builtin_amdgcn_s_waitcnt(0);
        unsigned nloc = b.st[0], nx = b.st[1];
        if (nloc == 0u) { xcd_barrier_complete(bar, b.x, nloc, nx); b.st[0] = nloc; b.st[1] = nx; }
        const unsigned old = xb_add(&bar[XB_XSUB(b.x)], 1u);
        const unsigned gen = old / nloc;
        if (old + 1u == (gen + 1u) * nloc) {
            __builtin_amdgcn_fence(__ATOMIC_RELEASE, "agent");
            asm volatile("s_waitcnt vmcnt(0)" ::: "memory");
            const unsigned og = xb_add(&bar[XB_TOP], 1u);
            const unsigned tg = og / nx;
            if (og + 1u == (tg + 1u) * nx) xb_add(&bar[XB_TOPGEN], 1u);
            else XB_SPIN(xb_ld(&bar[XB_TOPGEN]) == tg, bar);
            __builtin_amdgcn_fence(__ATOMIC_ACQUIRE, "agent");
            asm volatile("s_waitcnt vmcnt(0)" ::: "memory");
        } else {
            XB_SPIN(xb_ld(&bar[XB_TOPGEN]) == gen, bar);
            __builtin_amdgcn_fence(__ATOMIC_ACQUIRE, "agent");
            asm volatile("s_waitcnt vmcnt(0)" ::: "memory");
        }
    }
    __syncthreads();
}

template <class Elem>
__device__ __forceinline__ void gemm_small64(LAS unsigned char* lds, const bf16* A, const bf16* Bt, int K, int r0, int c0, const Elem& E) {
    int tid_ = threadIdx.x; asm volatile("" : "+v"(tid_));
    const int tid = tid_, lane = tid & 63, w = __builtin_amdgcn_readfirstlane(tid >> 6), fr = lane & 15, fq = lane >> 4;
    const int kw = K >> 3, k0 = w * kw;
    f32x4 acc[4][4];
#pragma unroll
    for (int i = 0; i < 4; ++i)
#pragma unroll
        for (int j = 0; j < 4; ++j) acc[i][j] = (f32x4){0.f, 0.f, 0.f, 0.f};
    const bf16* ap = A + (size_t)(r0 + fr) * K + k0 + 8 * fq;
    const bf16* bp = Bt + (size_t)(c0 + fr) * K + k0 + 8 * fq;
    const size_t s16 = (size_t)16 * K;
#pragma unroll 4
    for (int ks = 0; ks < kw; ks += 32) {
        bf16x8 a[4], b[4];
#pragma unroll
        for (int i = 0; i < 4; ++i) { a[i] = *(const bf16x8*)(ap + i * s16 + ks); b[i] = *(const bf16x8*)(bp + i * s16 + ks); }
#pragma unroll
        for (int rb = 0; rb < 4; ++rb)
#pragma unroll
            for (int cb = 0; cb < 4; ++cb) acc[rb][cb] = __builtin_amdgcn_mfma_f32_16x16x32_bf16(b[cb], a[rb], acc[rb][cb], 0, 0, 0);
    }
    LAS float* P = (LAS float*)lds;
#pragma unroll
    for (int rb = 0; rb < 4; ++rb)
#pragma unroll
        for (int cb = 0; cb < 4; ++cb) *(LAS f32x4*)(P + (w * 64 + rb * 16 + fr) * 68 + cb * 16 + 4 * fq) = acc[rb][cb];
    __syncthreads();
    const int row = tid >> 3, c8 = (tid & 7) * 8;
    f32x4 v0 = {0.f, 0.f, 0.f, 0.f}, v1 = {0.f, 0.f, 0.f, 0.f};
#pragma unroll
    for (int ww = 0; ww < 8; ++ww) { v0 += *(const LAS f32x4*)(P + (ww * 64 + row) * 68 + c8); v1 += *(const LAS f32x4*)(P + (ww * 64 + row) * 68 + c8 + 4); }
    float ss = E.elem8(r0 + row, c0 + c8, v0, v1);
    if (Elem::HAS_SS) { ss += __shfl_xor(ss, 1); ss += __shfl_xor(ss, 2); ss += __shfl_xor(ss, 4); if ((tid & 7) == 0) E.row_ss(r0 + row, c0 >> 6, ss); }
    __syncthreads();
}
struct ElemRes {
    static constexpr bool HAS_SS = true;
    bf16* XB; float* SS; float alpha;
    __device__ __forceinline__ float elem8(int r, int c, f32x4 a0, f32x4 a1) const {
        bf16* xp = XB + (size_t)r * D + c; float x[8]; unpack8(*(const v4u*)xp, x);
#pragma unroll
        for (int j = 0; j < 4; ++j) { x[j] += a0[j] * alpha; x[4 + j] += a1[j] * alpha; }
        *(v4u*)xp = pack8(x);
        float ss = 0.f;
#pragma unroll
        for (int j = 0; j < 8; ++j) ss += x[j] * x[j];
        return ss;
    }
    __device__ __forceinline__ void row_ss(int r, int slot, float ss) const { SS[(size_t)r * 16 + slot] = ss; }
};
struct ElemPle {
    static constexpr bool HAS_SS = false;
    const bf16* XB; const bf16* P; float* Y; const float* SS;
    __device__ __forceinline__ float elem8(int r, int c, f32x4 a0, f32x4 a1) const {
        const float rs = pg8::row_rs(SS, r); const size_t off = (size_t)r * D + c;
        float x[8], p[8]; unpack8(*(const v4u*)(XB + off), x); unpack8(*(const v4u*)(P + off), p); f32x4 o0, o1;
#pragma unroll
        for (int j = 0; j < 4; ++j) { o0[j] = x[j] + __builtin_amdgcn_rcpf(1.0f + __expf(-a0[j] * rs)) * p[j]; o1[j] = x[4 + j] + __builtin_amdgcn_rcpf(1.0f + __expf(-a1[j] * rs)) * p[4 + j]; }
        *(f32x4*)(Y + off) = o0; *(f32x4*)(Y + off + 4) = o1; return 0.f;
    }
    __device__ __forceinline__ void row_ss(int, int, float) const {}
};
struct ElemBf {
    static constexpr bool HAS_SS = false;
    bf16* P;
    __device__ __forceinline__ float elem8(int r, int c, f32x4 a0, f32x4 a1) const { float x[8] = {a0[0], a0[1], a0[2], a0[3], a1[0], a1[1], a1[2], a1[3]}; *(v4u*)(P + (size_t)r * D + c) = pack8(x); return 0.f; }
    __device__ __forceinline__ void row_ss(int, int, float) const {}
};
template <class Elem>
__device__ __forceinline__ void gemm_sample_rows(Frame& F, const bf16* A, const bf16* Bt, int K, const Elem& E) {
    for (int st = blockIdx.x; st < 256; st += F.G) gemm_small64<Elem>(F.lds, A, Bt, K, MP + 64 * (st >> 4), 64 * (st & 15), E);
}

__global__ void __launch_bounds__(NWAVES * 64, 2) fwd_megakernel(Args args) {
    extern __shared__ __attribute__((aligned(16))) unsigned char lds_raw[];
    cg::grid_group grid = cg::this_grid();
    Frame F;
    F.lds = (LAS unsigned char*)lds_raw; F.tid = threadIdx.x; F.lane = F.tid & 63; F.wave = __builtin_amdgcn_readfirstlane(F.tid >> 6); F.G = gridDim.x;
    const __attribute__((address_space(4))) Args* KA = (const __attribute__((address_space(4))) Args*)__builtin_amdgcn_kernarg_segment_ptr();
    F.a = KA; F.out = KA->out;
    unsigned char* ws = KA->ws;
    F.Z = (bf16*)(ws + WS_Z); F.MIX = (bf16*)(ws + WS_MIX); F.rope = (const f32x2*)(ws + WS_ROPE);
    bf16* XG = (bf16*)(ws + WS_XB); bf16* ACT = (bf16*)(ws + WS_ACT); bf16* PRJ = (bf16*)(ws + WS_PRJ); float* SS = (float*)(ws + WS_SS);
    const int lo = KA->ph_lo, hi = KA->ph_hi;
    const bool spread = (F.G == 256);
#ifndef PH_MASK
#define PH_MASK 0x1ff
#endif
#define IN(k) (((PH_MASK >> (k)) & 1) && lo <= (k) && (k) < hi)
    if (F.tid < 64) ((LAS unsigned*)(F.lds + OFF_MISC))[F.tid] = 0u;
    __syncthreads();
    const XcdBarrier bar = xcd_barrier_post((unsigned*)(ws + WS_CTL), (volatile LAS unsigned*)(F.lds + OFF_MISC));
    if (lo > 1000) grid.sync();
#define SEAM(k) do { if (IN(k) && IN((k) + 1)) xcd_barrier(bar); } while (0)
    if (IN(0)) { p0_prologue(F); } SEAM(0);
    if (IN(1)) {
        pg8::Gemm g{XG, (const bf16*)(ws + WS_W1T), MT, 2 * FF, D}; pg8::StaticOrder S; S.init(MT, 2 * FF, F.G, (int)blockIdx.x);
        pg8::EpiAct E{ACT, SS, FF};
        pg8::gemm_phase<pg8::EpiAct, pg8::StaticOrder, true, true>(F.lds, g, S, E);
        if (spread) {
            const int k = (int)blockIdx.x - 216; pg8::RangeOrder R{k >= 0 ? 2 * k : 0, k >= 0 ? 2 * k + 2 : 0};
            pg8::Gemm gp{(const bf16*)(ws + WS_PE), (const bf16*)(ws + WS_WPP), MP, D, DPLE}; pg8::EpiBf Ep{PRJ};
            pg8::gemm_phase<pg8::EpiBf, pg8::RangeOrder, true, true>(F.lds, gp, R, Ep);
        }
    } SEAM(1);
    if (IN(2)) {
        pg8::Gemm g{ACT, (const bf16*)(ws + WS_W1D), MP, D, FF}; pg8::StaticOrder S; S.init(MP, D, F.G, (int)blockIdx.x);
        pg8::EpiRes E{XG, SS, 0.5f};
        pg8::gemm_phase<pg8::EpiRes, pg8::StaticOrder, true, true>(F.lds, g, S, E);
        ElemRes Es{XG, SS, 0.5f};
        gemm_sample_rows<ElemRes>(F, ACT, (const bf16*)(ws + WS_W1D), FF, Es);
    } SEAM(2);
    if (IN(3)) {
        { pg8::Gemm g{XG, (const bf16*)(ws + WS_WIN), MT, NIN, D}; pg8::StaticOrder S; S.init(MT, NIN, F.G, (int)blockIdx.x);
          pg8::EpiZ E{F.Z, SS, NIN, 4};
          pg8::gemm_phase<pg8::EpiZ, pg8::StaticOrder, true, true>(F.lds, g, S, E); }
        if (spread) {
            const int k = (int)blockIdx.x - 220; const int f = k < 0 ? 0 : (k < 24 ? 160 + 3 * k : 232 + 2 * (k - 24)), n = k < 0 ? 0 : (k < 24 ? 3 : 2); pg8::RangeOrder R{f, f + n};
            pg8::Gemm gp{(const bf16*)(ws + WS_PE), (const bf16*)(ws + WS_WPP), MP, D, DPLE}; pg8::EpiBf Ep{PRJ};
            pg8::gemm_phase<pg8::EpiBf, pg8::RangeOrder, true, true>(F.lds, gp, R, Ep);
        }
    } SEAM(3);
    if (IN(4)) { p4_mixer(F); } SEAM(4);
    if (IN(5)) {
        pg8::Gemm g{F.MIX, (const bf16*)(ws + WS_WO), MP, D, D}; pg8::StaticOrder S; S.init(MP, D, F.G, (int)blockIdx.x);
        pg8::EpiRes E{XG, SS, 1.0f};
        pg8::gemm_phase<pg8::EpiRes, pg8::StaticOrder, true, true>(F.lds, g, S, E);
        ElemRes Es{XG, SS, 1.0f};
        gemm_sample_rows<ElemRes>(F, F.MIX, (const bf16*)(ws + WS_WO), D, Es);
    } SEAM(5);
    if (IN(6)) {
        pg8::Gemm g{XG, (const bf16*)(ws + WS_W2T), MT, 2 * FF, D}; pg8::StaticOrder S; S.init(MT, 2 * FF, F.G, (int)blockIdx.x);
        pg8::EpiAct E{ACT, SS, FF};
        pg8::gemm_phase<pg8::EpiAct, pg8::StaticOrder, true, true>(F.lds, g, S, E);
        if (spread) {
            const int k = (int)blockIdx.x - 216; pg8::RangeOrder R{k >= 0 ? 80 + 2 * k : 0, k >= 0 ? 80 + 2 * k + 2 : 0};
            pg8::Gemm gp{(const bf16*)(ws + WS_PE), (const bf16*)(ws + WS_WPP), MP, D, DPLE}; pg8::EpiBf Ep{PRJ};
            pg8::gemm_phase<pg8::EpiBf, pg8::RangeOrder, true, true>(F.lds, gp, R, Ep);
        }
    } SEAM(6);
    if (IN(7)) {
        pg8::Gemm g{ACT, (const bf16*)(ws + WS_W2D), MP, D, FF}; pg8::StaticOrder S; S.init(MP, D, F.G, (int)blockIdx.x);
        pg8::EpiRes E{XG, SS, 0.5f};
        pg8::gemm_phase<pg8::EpiRes, pg8::StaticOrder, true, true>(F.lds, g, S, E);
        ElemRes Es{XG, SS, 0.5f};
        gemm_sample_rows<ElemRes>(F, ACT, (const bf16*)(ws + WS_W2D), FF, Es);
    } SEAM(7);
    if (IN(8)) {
        pg8::Gemm g{(const bf16*)(ws + WS_PE), (const bf16*)(ws + WS_WPP), MP, D, DPLE}; pg8::StaticOrder S; S.init(MP, D, F.G, (int)blockIdx.x);
        pg8::EpiBf E{PRJ};
        if (!spread) pg8::gemm_phase<pg8::EpiBf, pg8::StaticOrder, true, true>(F.lds, g, S, E);
        ElemBf Es{PRJ};
        gemm_sample_rows<ElemBf>(F, (const bf16*)(ws + WS_PE), (const bf16*)(ws + WS_WPP), DPLE, Es);
        asm volatile("s_waitcnt vmcnt(0)" ::: "memory"); __syncthreads();
    }
    if (IN(8)) {
        pg8::Gemm g{XG, (const bf16*)(ws + WS_WPG), MP, D, D}; pg8::StaticOrder S; S.init(MP, D, F.G, (int)blockIdx.x);
        pg8::EpiPle E{XG, PRJ, F.out + OUT_Y, SS};
        pg8::gemm_phase<pg8::EpiPle, pg8::StaticOrder, true, true>(F.lds, g, S, E);
        ElemPle Es{XG, PRJ, F.out + OUT_Y, SS};
        gemm_sample_rows<ElemPle>(F, XG, (const bf16*)(ws + WS_WPG), D, Es);
    }
#undef IN
#undef SEAM
}

#ifndef MK_N_LAUNCHES
#define MK_N_LAUNCHES 1
#endif
extern "C" void kernel_launch(void* const* d_in, const int* in_sizes, int n_in, void* d_out, int out_size, void* d_ws, size_t ws_size, hipStream_t stream) {
    static int grid = 0;
    if (grid == 0) {
        if (n_in != 29 || out_size != (int)OUT_END || ws_size < WS_CTL + CTL_BYTES) { fprintf(stderr, "kernel_launch: unexpected shapes (n_in %d out %d ws %zu)\n", n_in, out_size, ws_size); grid = -1; return; }
        int dev = 0, cus = 0, per_cu = 0;
        hipGetDevice(&dev); hipDeviceGetAttribute(&cus, hipDeviceAttributeMultiprocessorCount, dev);
        if (hipFuncSetAttribute((const void*)fwd_megakernel, hipFuncAttributeMaxDynamicSharedMemorySize, LDS_BYTES) != hipSuccess) { fprintf(stderr, "kernel_launch: hipFuncSetAttribute failed\n"); grid = -1; return; }
        if (hipOccupancyMaxActiveBlocksPerMultiprocessor(&per_cu, (const void*)fwd_megakernel, NWAVES * 64, LDS_BYTES) != hipSuccess || per_cu < 1) { fprintf(stderr, "kernel_launch: occupancy query says %d\n", per_cu); per_cu = 1; }
        (void)hipGetLastError();
        grid = cus * per_cu;
        fprintf(stderr, "kernel_launch: grid %d (cus %d x %d)\n", grid, cus, per_cu);
    }
    if (grid < 0) return;
    Args a{};
    for (int i = 0; i < 29; ++i) a.in[i] = (const float*)d_in[i];
    a.out = (float*)d_out; a.ws = (unsigned char*)d_ws;
    if (hipMemsetAsync((char*)d_ws + WS_CTL, 0, CTL_BYTES, stream) != hipSuccess) { fprintf(stderr, "kernel_launch: memset failed\n"); return; }
    if (MK_N_LAUNCHES == 1) {
        a.ph_lo = 0; a.ph_hi = 9;
        void* kargs[] = {&a};
        const hipError_t e = hipLaunchCooperativeKernel((const void*)fwd_megakernel, dim3(grid), dim3(NWAVES * 64), kargs, LDS_BYTES, stream);
        if (e != hipSuccess) fprintf(stderr, "kernel_launch: cooperative launch failed: %s (grid %d)\n", hipGetErrorString(e), grid);
    } else {
        for (int p = 0; p < 9; ++p) { a.ph_lo = p; a.ph_hi = p + 1; hipLaunchKernelGGL(fwd_megakernel, dim3(grid), dim3(NWAVES * 64), LDS_BYTES, stream, a); }
    }
}
```

```cpp
#include <hip/hip_runtime.h>
#include <hip/hip_cooperative_groups.h>
#include <cstdio>
#include <cstdint>
#include <cmath>
namespace cg = cooperative_groups;
namespace pg8 {
#define PG8_LAS __attribute__((address_space(3)))
typedef unsigned short bf16_t;
typedef short bf16x8 __attribute__((ext_vector_type(8)));
typedef float f32x4 __attribute__((ext_vector_type(4)));
typedef unsigned u32x4 __attribute__((ext_vector_type(4)));
constexpr int BM = 256, BK = 64, HALF = 128, HTB = HALF * BK * 2  , STAGE_BYTES = 8 * HTB, NXCD = 8, WGM = 8;

__host__ __device__ __forceinline__ int lds_byte(int r, int c) { const int st = (r >> 4) * 2 + (c >> 5), rr = r & 15, cc = c & 31, ob = rr * 64 + cc * 2; return st * 1024 + (ob ^ (((ob >> 9) & 1) << 5)); }
__host__ __device__ __forceinline__ void stage_rc(int b, int& R, int& C) { const int st = b / 1024, sb = b % 1024, swz = sb ^ (((sb >> 9) & 1) << 5); R = (st >> 1) * 16 + swz / 64; C = (st & 1) * 32 + (swz % 64) / 2; }
__host__ __device__ __forceinline__ int perm32(int rho) { const int n = rho >> 4, i = rho & 15; return 8 * (i >> 2) + 4 * n + (i & 3); }

struct Unit { int pm, pn; };
struct Gemm { const bf16_t* A; const bf16_t* Bt; int M, N, K; };

struct StaticOrder {
    int nM, nN, nwg, G, c;
    __host__ __device__ void init(int M, int N, int G_, int c_) { nM = M / BM; nN = N / BM; nwg = nM * nN; G = G_; c = c_; }
    __host__ __device__ bool next(int i, Unit& u) const {
        const long L = (long)i * G + c; if (L >= nwg) return false;
        int wgid = (int)L; { const int q = nwg / NXCD, r = nwg % NXCD, xcd = wgid % NXCD, off = wgid / NXCD; wgid = (xcd < r ? xcd * (q + 1) : r * (q + 1) + (xcd - r) * q) + off; }
        const int nig = WGM * nN, gid = wgid / nig, fm = gid * WGM, gsz = (nM - fm) < WGM ? (nM - fm) : WGM;
        u.pm = fm + ((wgid % nig) % gsz); u.pn = (wgid % nig) / gsz; return true;
    }
    __device__ __forceinline__ void a_ready(const Unit&) const {}
    __device__ __forceinline__ void done(const Unit&) const {}
};

struct RangeOrder {
    int first, last;
    __host__ __device__ bool next(int i, Unit& u) const { const int idx = first + i; if (idx >= last) return false; u.pm = idx >> 2; u.pn = idx & 3; return true; }
    __device__ __forceinline__ void a_ready(const Unit&) const {}
    __device__ __forceinline__ void done(const Unit&) const {}
};

__device__ __forceinline__ unsigned cvt_pk_bf16(float lo, float hi) { unsigned r; asm volatile("v_cvt_pk_bf16_f32 %0, %1, %2" : "=v"(r) : "v"(lo), "v"(hi)); return r; }
__device__ __forceinline__ void store16_wt(void* p, u32x4 v) { asm volatile("global_store_dwordx4 %0, %1, off sc1\n\ts_nop 3" :: "v"(p), "v"(v) : "memory");     }
typedef float f32x2 __attribute__((ext_vector_type(2)));
__device__ __forceinline__ float fast_rcp(float x) { return __builtin_amdgcn_rcpf(x); }
__device__ __forceinline__ float row_rs(const float* SS, int r) {
    const f32x4* p = (const f32x4*)(SS + (size_t)r * 16);
    const f32x4 a = p[0], b = p[1], c = p[2], d = p[3];
    const f32x4 s = (a + b) + (c + d);
    const float t = (s[0] + s[1]) + (s[2] + s[3]);
    return __builtin_amdgcn_rsqf(t * (1.0f / 1024.0f) + 1e-6f);
}
__device__ __forceinline__ void row_rs8(const float* SS, int row0, int fq, float (&rsv)[2][4]) {
    f32x4 q[2][4];
#pragma unroll
    for (int ai = 0; ai < 2; ++ai)
#pragma unroll
        for (int m = 0; m < 4; ++m) q[ai][m] = *(const f32x4*)(SS + (size_t)(row0 + ai * HALF + m * 16) * 16 + 4 * fq);
#pragma unroll
    for (int ai = 0; ai < 2; ++ai)
#pragma unroll
        for (int m = 0; m < 4; ++m) { float t = (q[ai][m][0] + q[ai][m][1]) + (q[ai][m][2] + q[ai][m][3]); t += __shfl_xor(t, 16); t += __shfl_xor(t, 32); rsv[ai][m] = __builtin_amdgcn_rsqf(t * (1.0f / 1024.0f) + 1e-6f); }
}
struct EpiAct {
    static constexpr bool PERM = true, AFTER_DRAIN = false;
    bf16_t* O; const float* SS; int ldo;
    __device__ __forceinline__ void operator()(const f32x4 (&acc)[2][2][4][2], const Unit& u, int wr, int wc, int fr, int fq) const {
        const int row0 = u.pm * BM + wr * 64 + fr, col0 = u.pn * HALF + wc * 32 + 8 * fq;
        float rsv[2][4]; row_rs8(SS, row0, fq, rsv);
#pragma unroll
        for (int ai = 0; ai < 2; ++ai)
#pragma unroll
            for (int m = 0; m < 4; ++m) {
                const int r = row0 + ai * HALF + m * 16; const float rs = rsv[ai][m], nrs = rs * -1.4426950408889634f, rs2 = rs * rs;
                float o[8];
#pragma unroll
                for (int n = 0; n < 2; ++n) {
                    const f32x4 t = acc[ai][0][m][n] * nrs, p = (acc[ai][0][m][n] * acc[ai][1][m][n]) * rs2;
#pragma unroll
                    for (int j = 0; j < 4; ++j) o[4 * n + j] = p[j] * fast_rcp(1.0f + __builtin_amdgcn_exp2f(t[j]));
                }
                u32x4 w; w.x = cvt_pk_bf16(o[0], o[1]); w.y = cvt_pk_bf16(o[2], o[3]); w.z = cvt_pk_bf16(o[4], o[5]); w.w = cvt_pk_bf16(o[6], o[7]);
                store16_wt(O + (size_t)r * ldo + col0, w);
            }
    }
};
struct EpiRes {
    static constexpr bool PERM = true, AFTER_DRAIN = false;
    bf16_t* XB; float* SS; float alpha;
    __device__ __forceinline__ void operator()(const f32x4 (&acc)[2][2][4][2], const Unit& u, int wr, int wc, int fr, int fq) const {
        const int row0 = u.pm * BM + wr * 64 + fr, col0 = u.pn * BM + wc * 32 + 8 * fq;
        u32x4 rb[2][4][2];
#pragma unroll
        for (int ai = 0; ai < 2; ++ai)
#pragma unroll
            for (int m = 0; m < 4; ++m) { const bf16_t* xq = XB + (size_t)(row0 + ai * HALF + m * 16) * 1024 + col0; rb[ai][m][0] = *(const u32x4*)xq; rb[ai][m][1] = *(const u32x4*)(xq + HALF); }
#pragma unroll
        for (int ai = 0; ai < 2; ++ai) {
#pragma unroll
            for (int m = 0; m < 4; ++m) {
                const int r = row0 + ai * HALF + m * 16;
                bf16_t* xp = XB + (size_t)r * 1024 + col0;
                const u32x4 b0 = rb[ai][m][0], b1 = rb[ai][m][1];
                float ss = 0.f;
#pragma unroll
                for (int bj = 0; bj < 2; ++bj) {
                    const u32x4 b = bj ? b1 : b0;
                    f32x4 v0, v1;
                    v0[0] = __uint_as_float(b.x << 16); v0[1] = __uint_as_float(b.x & 0xffff0000u); v0[2] = __uint_as_float(b.y << 16); v0[3] = __uint_as_float(b.y & 0xffff0000u);
                    v1[0] = __uint_as_float(b.z << 16); v1[1] = __uint_as_float(b.z & 0xffff0000u); v1[2] = __uint_as_float(b.w << 16); v1[3] = __uint_as_float(b.w & 0xffff0000u);
                    v0 += acc[ai][bj][m][0] * alpha; v1 += acc[ai][bj][m][1] * alpha;
                    ss += (v0[0] * v0[0] + v0[1] * v0[1]) + (v0[2] * v0[2] + v0[3] * v0[3]) + (v1[0] * v1[0] + v1[1] * v1[1]) + (v1[2] * v1[2] + v1[3] * v1[3]);
                    u32x4 w; w.x = cvt_pk_bf16(v0[0], v0[1]); w.y = cvt_pk_bf16(v0[2], v0[3]); w.z = cvt_pk_bf16(v1[0], v1[1]); w.w = cvt_pk_bf16(v1[2], v1[3]);
                    *(u32x4*)(xp + bj * HALF) = w;
                }
                ss += __shfl_xor(ss, 16); ss += __shfl_xor(ss, 32);
                if (fq == 0) SS[(size_t)r * 16 + u.pn * 4 + wc] = ss;
            }
        }
    }
};
struct EpiZ {
    static constexpr bool PERM = true, AFTER_DRAIN = false;
    bf16_t* O; const float* SS; int ldo, gelu_tiles;
    __device__ __forceinline__ void operator()(const f32x4 (&acc)[2][2][4][2], const Unit& u, int wr, int wc, int fr, int fq) const {
        const int row0 = u.pm * BM + wr * 64 + fr, col0 = u.pn * BM + wc * 32 + 8 * fq;
        float rsv[2][4]; row_rs8(SS, row0, fq, rsv);
#pragma unroll
        for (int ai = 0; ai < 2; ++ai)
#pragma unroll
            for (int m = 0; m < 4; ++m) {
                const int r = row0 + ai * HALF + m * 16; const float rs = rsv[ai][m];
#pragma unroll
                for (int bj = 0; bj < 2; ++bj) {
                    f32x4 a = acc[ai][bj][m][0] * rs, b = acc[ai][bj][m][1] * rs;
                    if (u.pn < gelu_tiles) {
#pragma unroll
                        for (int j = 0; j < 4; ++j) { const float ua = 1.5957691216057308f * a[j] * (1.0f + 0.044715f * a[j] * a[j]), ub = 1.5957691216057308f * b[j] * (1.0f + 0.044715f * b[j] * b[j]);
                            a[j] = a[j] * fast_rcp(1.0f + __expf(-ua)); b[j] = b[j] * fast_rcp(1.0f + __expf(-ub)); }
                    }
                    u32x4 w; w.x = cvt_pk_bf16(a[0], a[1]); w.y = cvt_pk_bf16(a[2], a[3]); w.z = cvt_pk_bf16(b[0], b[1]); w.w = cvt_pk_bf16(b[2], b[3]);
                    *(u32x4*)(O + (size_t)r * ldo + col0 + bj * HALF) = w;
                }
            }
    }
};
struct EpiBf {
    static constexpr bool PERM = true, AFTER_DRAIN = false;
    bf16_t* P;
    __device__ __forceinline__ void operator()(const f32x4 (&acc)[2][2][4][2], const Unit& u, int wr, int wc, int fr, int fq) const {
        const int row0 = u.pm * BM + wr * 64 + fr, col0 = u.pn * BM + wc * 32 + 8 * fq;
#pragma unroll
        for (int ai = 0; ai < 2; ++ai)
#pragma unroll
            for (int m = 0; m < 4; ++m) {
                const int r = row0 + ai * HALF + m * 16;
#pragma unroll
                for (int bj = 0; bj < 2; ++bj) { const f32x4 a = acc[ai][bj][m][0], b = acc[ai][bj][m][1];
                    u32x4 w; w.x = cvt_pk_bf16(a[0], a[1]); w.y = cvt_pk_bf16(a[2], a[3]); w.z = cvt_pk_bf16(b[0], b[1]); w.w = cvt_pk_bf16(b[2], b[3]);
                    *(u32x4*)(P + (size_t)r * 1024 + col0 + bj * HALF) = w; }
            }
    }
};
struct EpiPle {
    static constexpr bool PERM = true, AFTER_DRAIN = false;
    const bf16_t* XB; const bf16_t* P; float* Y; const float* SS;
    __device__ __forceinline__ void operator()(const f32x4 (&acc)[2][2][4][2], const Unit& u, int wr, int wc, int fr, int fq) const {
        const int row0 = u.pm * BM + wr * 64 + fr, col0 = u.pn * BM + wc * 32 + 8 * fq;
        float rsv[2][4]; row_rs8(SS, row0, fq, rsv);
#pragma unroll
        for (int ai = 0; ai < 2; ++ai)
#pragma unroll
            for (int mp = 0; mp < 2; ++mp) {
                u32x4 xr[2][2], pr[2][2];
#pragma unroll
                for (int mm = 0; mm < 2; ++mm)
#pragma unroll
                    for (int bj = 0; bj < 2; ++bj) { const size_t off = (size_t)(row0 + ai * HALF + (2 * mp + mm) * 16) * 1024 + col0 + bj * HALF; xr[mm][bj] = *(const u32x4*)(XB + off); pr[mm][bj] = *(const u32x4*)(P + off); }
#pragma unroll
                for (int mm = 0; mm < 2; ++mm) {
                    const int m = 2 * mp + mm; const int r = row0 + ai * HALF + m * 16; const float nrs = rsv[ai][m] * -1.4426950408889634f;
#pragma unroll
                    for (int bj = 0; bj < 2; ++bj) {
                        const size_t off = (size_t)r * 1024 + col0 + bj * HALF;
                        const unsigned xw[4] = {xr[mm][bj].x, xr[mm][bj].y, xr[mm][bj].z, xr[mm][bj].w}, pw[4] = {pr[mm][bj].x, pr[mm][bj].y, pr[mm][bj].z, pr[mm][bj].w};
                        f32x4 o[2];
#pragma unroll
                        for (int q = 0; q < 4; ++q) {
                            const float t0 = acc[ai][bj][m][q >> 1][2 * (q & 1)] * nrs, t1 = acc[ai][bj][m][q >> 1][2 * (q & 1) + 1] * nrs;
                            o[q >> 1][2 * (q & 1)] = __uint_as_float(xw[q] << 16) + fast_rcp(1.0f + __builtin_amdgcn_exp2f(t0)) * __uint_as_float(pw[q] << 16);
                            o[q >> 1][2 * (q & 1) + 1] = __uint_as_float(xw[q] & 0xffff0000u) + fast_rcp(1.0f + __builtin_amdgcn_exp2f(t1)) * __uint_as_float(pw[q] & 0xffff0000u);
                        }
                        *(f32x4*)(Y + off) = o[0]; *(f32x4*)(Y + off + 4) = o[1];
                    }
                }
            }
    }
};

template <class Epi, class Sched, bool ALIGN_EPI = false, bool SP2 = false>
__device__ __forceinline__ void gemm_phase(PG8_LAS unsigned char* lds, const Gemm g, const Sched& S, const Epi& E) {
    int tid_ = threadIdx.x; asm volatile("" : "+v"(tid_));
    const int tid = tid_, wid = __builtin_amdgcn_readfirstlane(tid >> 6), lane = tid & 63, wr = wid >> 2, wc = wid & 3, fr = lane & 15, fq = lane >> 4;
    int K_ = g.K; asm volatile("" : "+s"(K_));
    const int K = K_, nt = K / BK;
    unsigned voffA[2], voffB[2];
#pragma unroll
    for (int i = 0; i < 2; ++i) { int R, C; stage_rc(tid * 16 + i * 8192, R, C); const int Rb = Epi::PERM ? ((R & ~31) + perm32(R & 31)) : R;
        voffA[i] = (unsigned)(R * K + C) * 2u; voffB[i] = (unsigned)(Rb * K + C) * 2u; }
    const size_t kstep = (size_t)(BK * 2);
    const size_t hstep = (size_t)HALF * K * 2;
    const size_t tstep = 2 * hstep;
    const unsigned ldsw = (unsigned)wid * 1024u;
    const int aoff = lds_byte(wr * 64 + fr, fq * 8), boff = lds_byte(wc * 32 + fr, fq * 8);
#define PG8_SA(b, h) (((b) * 2 + (h)) * HTB)
#define PG8_SB(b, h) ((4 + (b) * 2 + (h)) * HTB)
#define PG8_STAGE(bufoff, gbase, voff) do { _Pragma("unroll") for (int _i = 0; _i < 2; ++_i) \
        __builtin_amdgcn_global_load_lds((const unsigned*)((const char*)(gbase) + (voff)[_i]), (PG8_LAS unsigned*)(lds + (bufoff) + ldsw + _i * 8192), 16, 0, 0); } while (0)
#define PG8_LDA(dst, b, h) do { _Pragma("unroll") for (int m = 0; m < 4; ++m) _Pragma("unroll") for (int k = 0; k < 2; ++k) dst[m][k] = *(const PG8_LAS bf16x8*)(lds + PG8_SA(b, h) + aoff + m * 2048 + k * 1024); } while (0)
#define PG8_LDB(dst, b, h) do { _Pragma("unroll") for (int n = 0; n < 2; ++n) _Pragma("unroll") for (int k = 0; k < 2; ++k) dst[n][k] = *(const PG8_LAS bf16x8*)(lds + PG8_SB(b, h) + boff + n * 2048 + k * 1024); } while (0)
#define PG8_MMA(ai, bj, At, Bt) do { __builtin_amdgcn_s_setprio(1); _Pragma("unroll") for (int m = 0; m < 4; ++m) _Pragma("unroll") for (int n = 0; n < 2; ++n) _Pragma("unroll") for (int k = 0; k < 2; ++k) \
        acc[ai][bj][m][n] = __builtin_amdgcn_mfma_f32_16x16x32_bf16(Bt[n][k], At[m][k], acc[ai][bj][m][n], 0, 0, 0); __builtin_amdgcn_s_setprio(0); } while (0)
#define PG8_WAIT_V(n) asm volatile("s_waitcnt vmcnt(" #n ")" ::: "memory")
#define PG8_WAIT_L(n) asm volatile("s_waitcnt lgkmcnt(" #n ")" ::: "memory")
#define PG8_BAR __builtin_amdgcn_s_barrier()
#define PG8_SCHED __builtin_amdgcn_sched_barrier(0)
    Unit cur, nxt; int ui = 0;
    if (!S.next(0, cur)) return;
    f32x4 acc[2][2][4][2];
#pragma unroll
    for (int a = 0; a < 2; ++a)
#pragma unroll
        for (int b = 0; b < 2; ++b)
#pragma unroll
            for (int m = 0; m < 4; ++m)
#pragma unroll
                for (int n = 0; n < 2; ++n) acc[a][b][m][n] = (f32x4){0.f, 0.f, 0.f, 0.f};
    bf16x8 At[4][2], B0[2][2], B1[2][2];
    const char* cA = (const char*)g.A + (size_t)cur.pm * tstep; const char* cB = (const char*)g.Bt + (size_t)cur.pn * tstep;
    S.a_ready(cur);
    if constexpr (SP2) {
        PG8_STAGE(PG8_SB(0, 0), cB, voffB); PG8_STAGE(PG8_SB(0, 1), cB + hstep, voffB); PG8_STAGE(PG8_SA(0, 0), cA, voffA); PG8_STAGE(PG8_SA(0, 1), cA + hstep, voffA);
        if (wr == 1) PG8_BAR;
        PG8_WAIT_V(2); PG8_BAR;
        PG8_STAGE(PG8_SB(1, 0), cB + kstep, voffB); PG8_STAGE(PG8_SA(1, 0), cA + kstep, voffA); PG8_STAGE(PG8_SB(1, 1), cB + hstep + kstep, voffB);
        PG8_WAIT_V(6); PG8_BAR;
    } else {
        PG8_STAGE(PG8_SB(0, 0), cB, voffB); PG8_STAGE(PG8_SA(0, 0), cA, voffA); PG8_STAGE(PG8_SB(0, 1), cB + hstep, voffB); PG8_STAGE(PG8_SA(0, 1), cA + hstep, voffA);
        if (wr == 1) PG8_BAR;
        PG8_WAIT_V(4); PG8_BAR;
        PG8_STAGE(PG8_SB(1, 0), cB + kstep, voffB); PG8_STAGE(PG8_SA(1, 0), cA + kstep, voffA); PG8_STAGE(PG8_SB(1, 1), cB + hstep + kstep, voffB);
        PG8_WAIT_V(6); PG8_BAR;
    }
    for (;;) {
        const bool has_next = S.next(ui + 1, nxt);
        const char* nA = has_next ? (const char*)g.A + (size_t)nxt.pm * tstep : cA; const char* nB = has_next ? (const char*)g.Bt + (size_t)nxt.pn * tstep : cB;
        for (int t = 0; t < nt; t += 2) {
            const bool last = (t == nt - 2);
            const char* a1 = cA + (size_t)(t + 1) * kstep;
            const char* a2 = last ? nA : cA + (size_t)(t + 2) * kstep; const char* b2 = last ? nB : cB + (size_t)(t + 2) * kstep;
            const char* a3 = a2 + kstep; const char* b3 = b2 + kstep;
            if (last && has_next) S.a_ready(nxt);
            if constexpr (SP2) {
            PG8_LDB(B0, 0, 0); PG8_LDB(B1, 0, 1); PG8_SCHED; PG8_LDA(At, 0, 0); PG8_STAGE(PG8_SA(1, 1), a1 + hstep, voffA);
            PG8_WAIT_V(8); PG8_WAIT_L(0); PG8_BAR; PG8_MMA(0, 0, At, B0); PG8_MMA(0, 1, At, B1); PG8_BAR; PG8_SCHED;
            PG8_LDA(At, 0, 1); PG8_STAGE(PG8_SB(0, 0), b2, voffB); PG8_STAGE(PG8_SB(0, 1), b2 + hstep, voffB); PG8_STAGE(PG8_SA(0, 0), a2, voffA);
            PG8_WAIT_V(8); PG8_WAIT_L(0); PG8_BAR; PG8_MMA(1, 0, At, B0); PG8_MMA(1, 1, At, B1); PG8_BAR; PG8_SCHED;
            PG8_LDB(B0, 1, 0); PG8_LDB(B1, 1, 1); PG8_SCHED; PG8_LDA(At, 1, 0); PG8_STAGE(PG8_SA(0, 1), a2 + hstep, voffA);
            PG8_WAIT_V(8); PG8_WAIT_L(0); PG8_BAR; PG8_MMA(0, 0, At, B0); PG8_MMA(0, 1, At, B1); PG8_BAR; PG8_SCHED;
            PG8_LDA(At, 1, 1); PG8_STAGE(PG8_SB(1, 0), b3, voffB); PG8_STAGE(PG8_SB(1, 1), b3 + hstep, voffB); PG8_STAGE(PG8_SA(1, 0), a3, voffA);
            PG8_WAIT_V(8); PG8_WAIT_L(0); PG8_BAR; PG8_MMA(1, 0, At, B0); PG8_MMA(1, 1, At, B1); PG8_BAR; PG8_SCHED;
            } else {
            PG8_LDB(B0, 0, 0); PG8_SCHED; PG8_LDA(At, 0, 0); PG8_STAGE(PG8_SA(1, 1), a1 + hstep, voffA);
            PG8_WAIT_L(8); PG8_BAR; PG8_WAIT_L(0); PG8_MMA(0, 0, At, B0); PG8_BAR; PG8_SCHED;
            PG8_LDB(B1, 0, 1); PG8_STAGE(PG8_SB(0, 0), b2, voffB);
            PG8_BAR; PG8_WAIT_L(0); PG8_MMA(0, 1, At, B1); PG8_BAR;
            PG8_LDA(At, 0, 1); PG8_STAGE(PG8_SA(0, 0), a2, voffA);
            PG8_BAR; PG8_WAIT_L(0); PG8_MMA(1, 0, At, B0); PG8_BAR; PG8_SCHED;
            PG8_STAGE(PG8_SB(0, 1), b2 + hstep, voffB);
            PG8_WAIT_V(6); PG8_BAR; PG8_MMA(1, 1, At, B1); PG8_BAR;
            PG8_LDB(B0, 1, 0); PG8_SCHED; PG8_LDA(At, 1, 0); PG8_STAGE(PG8_SA(0, 1), a2 + hstep, voffA);
            PG8_WAIT_L(8); PG8_BAR; PG8_WAIT_L(0); PG8_MMA(0, 0, At, B0); PG8_BAR; PG8_SCHED;
            PG8_LDB(B1, 1, 1); PG8_STAGE(PG8_SB(1, 0), b3, voffB);
            PG8_BAR; PG8_WAIT_L(0); PG8_MMA(0, 1, At, B1); PG8_BAR;
            PG8_LDA(At, 1, 1); PG8_STAGE(PG8_SA(1, 0), a3, voffA);
            PG8_BAR; PG8_WAIT_L(0); PG8_MMA(1, 0, At, B0); PG8_BAR; PG8_SCHED;
            PG8_STAGE(PG8_SB(1, 1), b3 + hstep, voffB);
            PG8_WAIT_V(6); PG8_BAR; PG8_MMA(1, 1, At, B1); PG8_BAR;
            }
        }
        if constexpr (ALIGN_EPI) { if (wr == 0) PG8_BAR; }
        if constexpr (!Epi::AFTER_DRAIN) { E(acc, cur, wr, wc, fr, fq); S.done(cur); }
        if (!has_next) break;
#pragma unroll
        for (int a = 0; a < 2; ++a)
#pragma unroll
            for (int b = 0; b < 2; ++b)
#pragma unroll
                for (int m = 0; m < 4; ++m)
#pragma unroll
                    for (int n = 0; n < 2; ++n) acc[a][b][m][n] = (f32x4){0.f, 0.f, 0.f, 0.f};
        cur = nxt; cA = nA; cB = nB; ++ui;
        if constexpr (ALIGN_EPI) { if (wr == 1) PG8_BAR; }
    }
    PG8_WAIT_V(0);
    if constexpr (!ALIGN_EPI) { if (wr == 0) PG8_BAR; }
    PG8_BAR;
    if constexpr (Epi::AFTER_DRAIN) { E.fused(acc, cur, wr, wc, fr, fq, lds, wid, lane); S.done(cur); }
#undef PG8_SA
#undef PG8_SB
#undef PG8_STAGE
#undef PG8_LDA
#undef PG8_LDB
#undef PG8_MMA
#undef PG8_WAIT_V
#undef PG8_WAIT_L
#undef PG8_BAR
#undef PG8_SCHED
}
}
constexpr int NWAVES = 8;
constexpr int MP = 16384, MS = 1024, MT = MP + MS;
constexpr int D = 1024, FF = 2816, NIN = 1792, DPLE = 256, SEQ = 2048, PAST = 16384;
constexpr int ROPE_ROWS = 2048 + 8;
constexpr size_t OUT_Y = 0, OUT_PKW = 17825792, OUT_PVW = 17956864, OUT_PCV = 18087936, OUT_SKW = 18612224, OUT_SVW = 20709376, OUT_SCV = 22806528, OUT_END = 23330816;
constexpr size_t WS_W1T = 0, WS_W1D = WS_W1T + 11534336, WS_WIN = WS_W1D + 5767168, WS_WO = WS_WIN + 3670016, WS_W2T = WS_WO + 2097152, WS_W2D = WS_W2T + 11534336,
                 WS_WPG = WS_W2D + 5767168, WS_WPP = WS_WPG + 2097152, WS_R = WS_WPP + 524288;
constexpr size_t WS_ACT = WS_R, WS_Z = WS_R, WS_MIX = WS_R + (size_t)MT * NIN * 2;
constexpr size_t WS_PRJ = WS_R + (size_t)MT * FF * 2, WS_XB = WS_PRJ + (size_t)MT * D * 2, WS_SS = WS_XB + (size_t)MT * D * 2, WS_PE = WS_SS + (size_t)MT * 16 * 4,
                 WS_ROPE = WS_PE + (size_t)MT * DPLE * 2, WS_END = WS_ROPE + (size_t)ROPE_ROWS * 32 * 8;
constexpr int XCD_BAR_WORDS_C = 3456;
constexpr size_t WS_CTL = WS_END, CTL_BYTES = 16384;
static_assert(WS_MIX + (size_t)MT * D * 2 <= WS_PRJ && WS_CTL % 256 == 0 && WS_CTL + CTL_BYTES <= 268435456 && XCD_BAR_WORDS_C * 4 <= CTL_BYTES, "d_ws map");
constexpr int LDS_BYTES = 155648, OFF_MISC = LDS_BYTES - 256;

#define LAS __attribute__((address_space(3)))
typedef unsigned short bf16;
typedef unsigned v4u __attribute__((ext_vector_type(4)));
typedef unsigned v2u __attribute__((ext_vector_type(2)));
typedef float f32x4 __attribute__((ext_vector_type(4)));
typedef float f32x2 __attribute__((ext_vector_type(2)));
typedef short bf16x8 __attribute__((ext_vector_type(8)));
using pg8::cvt_pk_bf16;

struct Args {
    const float* in[29]; float* out; unsigned char* ws; int ph_lo, ph_hi;
};

struct Frame {
    LAS unsigned char* lds; int tid, lane, wave, G;
    const __attribute__((address_space(4))) Args* a; float* out;
    bf16 *Z, *MIX; const f32x2* rope;
};

__device__ __forceinline__ float wave_sum(float v) {
#pragma unroll
    for (int o = 1; o < 64; o <<= 1) v += __shfl_xor(v, o);
    return v;
}
__device__ __forceinline__ float bf2f(unsigned short h) { return __uint_as_float((unsigned)h << 16); }
__device__ __forceinline__ void unpack2(unsigned w, float& lo, float& hi) { lo = __uint_as_float(w << 16); hi = __uint_as_float(w & 0xffff0000u); }
__device__ __forceinline__ void unpack8(const v4u w, float* f) { unpack2(w.x, f[0], f[1]); unpack2(w.y, f[2], f[3]); unpack2(w.z, f[4], f[5]); unpack2(w.w, f[6], f[7]); }
__device__ __forceinline__ v4u pack8(const float* f) { v4u w; w.x = cvt_pk_bf16(f[0], f[1]); w.y = cvt_pk_bf16(f[2], f[3]); w.z = cvt_pk_bf16(f[4], f[5]); w.w = cvt_pk_bf16(f[6], f[7]); return w; }
__device__ __forceinline__ bf16x8 as_bf16x8(const v4u w) { return __builtin_bit_cast(bf16x8, w); }
__device__ __forceinline__ float gelu_tanh(float x) {
    const float u = 1.5957691216057308f * x * (1.0f + 0.044715f * x * x);
    return x * __builtin_amdgcn_rcpf(1.0f + __expf(-u));
}

struct TItem { const float* W; const float* gk; bf16* WT; int K, N, mode, item; };
struct TRegs { f32x4 v[8]; };
__device__ __forceinline__ TRegs t_load(const TItem& t, int lane) {
    const int nblk = t.N / 32, kb = t.item / nblk, nb = t.item % nblk, k0 = 64 * kb, n0 = 32 * nb; TRegs r;
    const float* p = t.W + (size_t)(k0 + (lane >> 3)) * t.N + n0 + 4 * (lane & 7);
#pragma unroll
    for (int i = 0; i < 8; ++i) r.v[i] = *(const f32x4*)(p + (size_t)(8 * i) * t.N);
    if (t.gk) {
#pragma unroll
        for (int i = 0; i < 8; ++i) r.v[i] = r.v[i] * t.gk[k0 + (lane >> 3) + 8 * i];
    }
    return r;
}
__device__ __forceinline__ void t_store(const TItem& t, const TRegs& r, LAS float* scr, int lane) {
    const int nblk = t.N / 32, kb = t.item / nblk, nb = t.item % nblk, k0 = 64 * kb, n0 = 32 * nb;
    const int rbase = (t.mode == 0) ? n0 : (((n0 >> 7) << 8) + (n0 & 127) + (t.mode == 2 ? 128 : 0));
#pragma unroll
    for (int i = 0; i < 8; ++i) { LAS float* d = scr + ((lane >> 3) + 8 * i) * 33 + 4 * (lane & 7); d[0] = r.v[i][0]; d[1] = r.v[i][1]; d[2] = r.v[i][2]; d[3] = r.v[i][3]; }
    asm volatile("s_waitcnt lgkmcnt(0)" ::: "memory");
    const int c = lane & 7;
#pragma unroll
    for (int j = 0; j < 4; ++j) { const int n = (lane >> 3) + 8 * j; const LAS float* s = scr + (8 * c) * 33 + n;
        v4u o; o.x = cvt_pk_bf16(s[0 * 33], s[1 * 33]); o.y = cvt_pk_bf16(s[2 * 33], s[3 * 33]); o.z = cvt_pk_bf16(s[4 * 33], s[5 * 33]); o.w = cvt_pk_bf16(s[6 * 33], s[7 * 33]);
        *(v4u*)(t.WT + (size_t)(rbase + n) * t.K + k0 + 8 * c) = o; }
    asm volatile("s_waitcnt lgkmcnt(0)" ::: "memory");
}
__device__ __forceinline__ TItem t_decode(Frame& F, int it) {
    const __attribute__((address_space(4))) Args& A = *F.a; unsigned char* ws = A.ws;
    constexpr int I_FU = (D / 64) * (FF / 32), I_IN = (D / 64) * (NIN / 32), I_SQ = (D / 64) * (D / 32);
    TItem t; int r = it;
    if (r < I_FU) { t = TItem{A.in[7], A.in[6], (bf16*)(ws + WS_W1T), D, FF, 1, r}; return t; } r -= I_FU;
    if (r < I_FU) { t = TItem{A.in[8], A.in[6], (bf16*)(ws + WS_W1T), D, FF, 2, r}; return t; } r -= I_FU;
    if (r < I_FU) { t = TItem{A.in[9], nullptr, (bf16*)(ws + WS_W1D), FF, D, 0, r}; return t; } r -= I_FU;
    if (r < I_FU) { t = TItem{A.in[23], A.in[22], (bf16*)(ws + WS_W2T), D, FF, 1, r}; return t; } r -= I_FU;
    if (r < I_FU) { t = TItem{A.in[24], A.in[22], (bf16*)(ws + WS_W2T), D, FF, 2, r}; return t; } r -= I_FU;
    if (r < I_FU) { t = TItem{A.in[25], nullptr, (bf16*)(ws + WS_W2D), FF, D, 0, r}; return t; } r -= I_FU;
    if (r < I_IN) { t = TItem{A.in[11], A.in[10], (bf16*)(ws + WS_WIN), D, NIN, 0, r}; return t; } r -= I_IN;
    if (r < I_SQ) { t = TItem{A.in[21], nullptr, (bf16*)(ws + WS_WO), D, D, 0, r}; return t; } r -= I_SQ;
    if (r < I_SQ) { t = TItem{A.in[27], A.in[26], (bf16*)(ws + WS_WPG), D, D, 0, r}; return t; } r -= I_SQ;
    t = TItem{A.in[28], nullptr, (bf16*)(ws + WS_WPP), DPLE, D, 0, r}; return t;
}
__device__ __forceinline__ void p0_prologue(Frame& F) {
    const __attribute__((address_space(4))) Args& A = *F.a; unsigned char* ws = A.ws;
    LAS float* scr = (LAS float*)(F.lds + F.wave * 16384);
    const int gw = blockIdx.x * NWAVES + F.wave, NGW = F.G * NWAVES;
    constexpr int I_FU = (D / 64) * (FF / 32), I_FD = (FF / 64) * (D / 32), I_IN = (D / 64) * (NIN / 32), I_SQ = (D / 64) * (D / 32), I_PP = (DPLE / 64) * (D / 32);
    constexpr int NITEMS = 6 * I_FU + I_IN + 2 * I_SQ + I_PP;
    static_assert(I_FU == I_FD, "");
    {
        TItem t0 = t_decode(F, gw < NITEMS ? gw : 0), t1 = t_decode(F, gw + NGW < NITEMS ? gw + NGW : 0);
        TRegs r0 = t_load(t0, F.lane), r1 = t_load(t1, F.lane);
#pragma unroll 1
        for (int it = gw; it < NITEMS; it += 2 * NGW) {
            const int n0 = it + 2 * NGW, n1 = it + 3 * NGW;
            const TItem u0 = t_decode(F, n0 < NITEMS ? n0 : 0), u1 = t_decode(F, n1 < NITEMS ? n1 : 0);
            const TRegs q0 = t_load(u0, F.lane), q1 = t_load(u1, F.lane);
            t_store(t0, r0, scr, F.lane);
            if (it + NGW < NITEMS) t_store(t1, r1, scr, F.lane);
            t0 = u0; t1 = u1; r0 = q0; r1 = q1;
        }
    }
    bf16* XB = (bf16*)(ws + WS_XB); float* SS = (float*)(ws + WS_SS); bf16* PE = (bf16*)(ws + WS_PE);
#pragma unroll 1
    for (int m0 = gw; m0 < MT; m0 += 2 * NGW) {
        f32x4 v[2][4], pv[2]; int mm[2];
#pragma unroll
        for (int q = 0; q < 2; ++q) {
            const int m = (m0 + q * NGW < MT) ? m0 + q * NGW : m0; mm[q] = m;
            const float* xrow = (m < MP) ? A.in[0] + (size_t)m * D : A.in[1] + (size_t)(m - MP) * D;
            const float* prow = (m < MP) ? A.in[2] + (size_t)m * DPLE : A.in[3] + (size_t)(m - MP) * DPLE;
#pragma unroll
            for (int j = 0; j < 4; ++j) v[q][j] = *((const f32x4*)xrow + F.lane + 64 * j);
            pv[q] = *((const f32x4*)prow + F.lane);
        }
#pragma unroll
        for (int q = 0; q < 2; ++q) {
            const int m = mm[q]; float s = 0.f;
#pragma unroll
            for (int j = 0; j < 4; ++j) s += (v[q][j][0] * v[q][j][0] + v[q][j][1] * v[q][j][1]) + (v[q][j][2] * v[q][j][2] + v[q][j][3] * v[q][j][3]);
            s = wave_sum(s);
            v2u* o8 = (v2u*)(XB + (size_t)m * D) + F.lane;
#pragma unroll
            for (int j = 0; j < 4; ++j) { v2u w; w.x = cvt_pk_bf16(v[q][j][0], v[q][j][1]); w.y = cvt_pk_bf16(v[q][j][2], v[q][j][3]); o8[64 * j] = w; }
            if (F.lane < 16) SS[(size_t)m * 16 + F.lane] = (F.lane == 0) ? s : 0.f;
            v2u w; w.x = cvt_pk_bf16(pv[q][0], pv[q][1]); w.y = cvt_pk_bf16(pv[q][2], pv[q][3]);
            *((v2u*)(PE + (size_t)m * DPLE) + F.lane) = w;
        }
    }
    f32x2* rope = (f32x2*)(ws + WS_ROPE);
    for (int e = blockIdx.x * (NWAVES * 64) + F.tid; e < ROPE_ROWS * 32; e += F.G * NWAVES * 64) {
        const int pr = e >> 5, i = e & 31; const int pos = pr < 2048 ? pr : PAST + (pr - 2048);
        const double inv = (double)exp2f(-(float)i * (13.287712379549449f / 32.0f));
        double t = (double)pos * inv * 0.15915494309189535; t -= floor(t);
        const float f = (float)t;
        rope[e] = (f32x2){__builtin_amdgcn_cosf(f), __builtin_amdgcn_sinf(f)};
    }
}

constexpr int VT_A = 136;
constexpr int KP = 72, VP = 264;
constexpr int LDS_PART = 141312 + 4096 - 4096;
constexpr int OFF_PART = 141312, OFF_RED = OFF_PART + 4096, OFF_STAT = OFF_RED + 1024;
static_assert(512 * VT_A * 2 <= OFF_PART && 2 * 256 * KP * 2 + 2 * 64 * VP * 2 <= OFF_PART && OFF_STAT + 1024 <= OFF_MISC, "mixer LDS map");

template <int PW>
__device__ __forceinline__ void finalize_rows(Frame& F, size_t m0, int coloff, const float* g) {
    const LAS float* part = (const LAS float*)(F.lds + OFF_PART);
    float gv[8];
#pragma unroll
    for (int j = 0; j < 8; ++j) gv[j] = g[8 * F.lane + j];
    constexpr int BATCH = PW < 8 ? PW : 8;
#pragma unroll 1
    for (int i0 = 0; i0 < PW; i0 += BATCH) {
        v4u raw[BATCH];
#pragma unroll
        for (int i = 0; i < BATCH; ++i) raw[i] = *(const v4u*)(F.MIX + (m0 + F.wave * PW + i0 + i) * D + coloff + 8 * F.lane);
#pragma unroll
        for (int i = 0; i < BATCH; ++i) {
            const int tt = F.wave * PW + i0 + i;
            const f32x4 p0 = *(const LAS f32x4*)(part + tt * 8), p1 = *(const LAS f32x4*)(part + tt * 8 + 4);
            const float tot = ((p0[0] + p0[1]) + (p0[2] + p0[3])) + ((p1[0] + p1[1]) + (p1[2] + p1[3]));
            const float rs = __builtin_amdgcn_rsqf(tot * (1.0f / 512.0f) + 1e-6f);
            float x[8]; unpack8(raw[i], x);
#pragma unroll
            for (int j = 0; j < 8; ++j) x[j] = x[j] * rs * gv[j];
            *(v4u*)(F.MIX + (m0 + tt) * D + coloff + 8 * F.lane) = pack8(x);
        }
    }
}

__device__ __forceinline__ void mix_prompt_A(Frame& F, int n, int c) {
    const __attribute__((address_space(4))) Args& A = *F.a;
    LAS bf16* Vt = (LAS bf16*)F.lds; LAS float* part = (LAS float*)(F.lds + OFF_PART); LAS float* stat = (LAS float*)(F.lds + OFF_STAT);
    const size_t m0 = (size_t)n * SEQ + (size_t)c * 128; const int lane = F.lane, w = F.wave, tid = F.tid;
#pragma unroll 1
    for (int i0 = 0; i0 < 16; i0 += 8) {
        v4u raw[8];
#pragma unroll
        for (int i = 0; i < 8; ++i) raw[i] = *(const v4u*)(F.Z + (m0 + w * 16 + i0 + i) * NIN + 512 + 8 * lane);
        float sm[8], sq[8];
#pragma unroll
        for (int i = 0; i < 8; ++i) { float x[8]; unpack8(raw[i], x); float a = 0.f, b = 0.f;
#pragma unroll
            for (int j = 0; j < 8; ++j) { a += x[j]; b += x[j] * x[j]; }
            sm[i] = a; sq[i] = b; }
#pragma unroll
        for (int o = 1; o < 64; o <<= 1) {
#pragma unroll
            for (int i = 0; i < 8; ++i) { sm[i] += __shfl_xor(sm[i], o); sq[i] += __shfl_xor(sq[i], o); } }
        if (lane == 0) {
#pragma unroll
            for (int i = 0; i < 8; ++i) { const float mean = sm[i] * (1.0f / 512.0f), var = fmaxf(sq[i] * (1.0f / 512.0f) - mean * mean, 0.f);
                stat[2 * (w * 16 + i0 + i)] = mean; stat[2 * (w * 16 + i0 + i) + 1] = __builtin_amdgcn_rsqf(var + 1e-6f); }
        }
    }
    __syncthreads();
    {
        const int col = tid; const float gc = A.in[12][col], bc = A.in[13][col];
        const bf16* zc = F.Z + m0 * NIN + 512 + col;
        float* cv = F.out + OUT_PCV + ((size_t)n * 128) * 512 + col;
#pragma unroll 1
        for (int g32 = 0; g32 < 4; ++g32) {
            unsigned short hv[32];
#pragma unroll
            for (int j = 0; j < 32; ++j) hv[j] = zc[(size_t)(32 * g32 + j) * NIN];
#pragma unroll
            for (int q = 0; q < 4; ++q) {
                float y[8];
#pragma unroll
                for (int j = 0; j < 8; ++j) { const int tt = 32 * g32 + 8 * q + j; const f32x2 st = *(const LAS f32x2*)(stat + 2 * tt); y[j] = (bf2f(hv[8 * q + j]) - st.x) * st.y * gc + bc; }
                if (c == 15) {
#pragma unroll
                    for (int j = 0; j < 8; ++j) cv[(size_t)(32 * g32 + 8 * q + j) * 512] = y[j];
                }
                *(LAS v4u*)(Vt + col * VT_A + 32 * g32 + 8 * q) = pack8(y);
            }
        }
    }
    __syncthreads();
    {
        const int h = w, fr = lane & 15, fq = lane >> 4;
        const float* wbase = A.in[14] + (size_t)h * 128 * 128 + 8 * fq; const float* bsb = A.in[15] + h * 128;
#pragma unroll
        for (int half = 0; half < 4; ++half) {
            f32x4 wa[2][4], wb[2][4]; v2u ur[2][4]; float bias[2];
#pragma unroll
            for (int q = 0; q < 2; ++q) {
                const int tb = 2 * half + q, t = tb * 16 + fr, nks = tb / 2 + 1;
#pragma unroll
                for (int ks = 0; ks < 4; ++ks) if (ks < nks) { const float* wp = wbase + (size_t)t * 128 + 32 * ks; wa[q][ks] = *(const f32x4*)wp; wb[q][ks] = *(const f32x4*)(wp + 4); }
#pragma unroll
                for (int db = 0; db < 4; ++db) ur[q][db] = *(const v2u*)(F.Z + (m0 + t) * NIN + 64 * h + 16 * db + 4 * fq);
                bias[q] = bsb[t];
            }
#pragma unroll
            for (int q = 0; q < 2; ++q) {
                const int tb = 2 * half + q, t = tb * 16 + fr, nks = tb / 2 + 1;
                bf16x8 Y[4];
#pragma unroll
                for (int ks = 0; ks < 4; ++ks) if (ks < nks) {
                    const int s0 = 32 * ks + 8 * fq; float f[8];
#pragma unroll
                    for (int j = 0; j < 4; ++j) { f[j] = (s0 + j <= t) ? wa[q][ks][j] : 0.f; f[4 + j] = (s0 + 4 + j <= t) ? wb[q][ks][j] : 0.f; }
                    Y[ks] = as_bf16x8(pack8(f));
                }
                float ssq = 0.f;
#pragma unroll
                for (int db = 0; db < 4; ++db) {
                    f32x4 acc = {0.f, 0.f, 0.f, 0.f};
#pragma unroll
                    for (int ks = 0; ks < 4; ++ks) if (ks < nks) {
                        const bf16x8 X = *(const LAS bf16x8*)(Vt + (64 * h + 16 * db + fr) * VT_A + 32 * ks + 8 * fq);
                        acc = __builtin_amdgcn_mfma_f32_16x16x32_bf16(X, Y[ks], acc, 0, 0, 0);
                    }
                    float u0, u1, u2, u3; unpack2(ur[q][db].x, u0, u1); unpack2(ur[q][db].y, u2, u3);
                    const float a0 = u0 * (acc[0] + bias[q]), a1 = u1 * (acc[1] + bias[q]), a2 = u2 * (acc[2] + bias[q]), a3 = u3 * (acc[3] + bias[q]);
                    ssq += (a0 * a0 + a1 * a1) + (a2 * a2 + a3 * a3);
                    v2u o; o.x = cvt_pk_bf16(a0, a1); o.y = cvt_pk_bf16(a2, a3);
                    *(v2u*)(F.MIX + (m0 + t) * D + 64 * h + 16 * db + 4 * fq) = o;
                }
                ssq += __shfl_xor(ssq, 16); ssq += __shfl_xor(ssq, 32);
                if (fq == 0) part[t * 8 + h] = ssq;
            }
        }
    }
    __syncthreads();
    finalize_rows<16>(F, m0, 0, A.in[19]);
}

__device__ __forceinline__ void k_norm_rope(Frame& F, const bf16* zk, int prow, LAS bf16* krow, float* kout) {
    const __attribute__((address_space(4))) Args& A = *F.a; const float* gk = A.in[17];
    float ss = 0.f;
#pragma unroll
    for (int i = 0; i < 8; ++i) { float x[8]; unpack8(*(const v4u*)(zk + 8 * i), x);
#pragma unroll
        for (int j = 0; j < 8; ++j) ss += x[j] * x[j]; }
    const float rs = __builtin_amdgcn_rsqf(ss * (1.0f / 64.0f) + 1e-6f);
    const f32x2* tab = F.rope + prow * 32;
#pragma unroll 1
    for (int i = 0; i < 4; ++i) {
        float x1[8], x2[8], o1[8], o2[8]; unpack8(*(const v4u*)(zk + 8 * i), x1); unpack8(*(const v4u*)(zk + 32 + 8 * i), x2);
#pragma unroll
        for (int j = 0; j < 8; ++j) { const float a = x1[j] * rs * gk[8 * i + j], b = x2[j] * rs * gk[32 + 8 * i + j]; const f32x2 cs = tab[8 * i + j]; o1[j] = a * cs.x - b * cs.y; o2[j] = b * cs.x + a * cs.y; }
        *(LAS v4u*)(krow + 8 * i) = pack8(o1); *(LAS v4u*)(krow + 32 + 8 * i) = pack8(o2);
        if (kout) {
            *(f32x4*)(kout + 8 * i) = (f32x4){o1[0], o1[1], o1[2], o1[3]}; *(f32x4*)(kout + 8 * i + 4) = (f32x4){o1[4], o1[5], o1[6], o1[7]};
            *(f32x4*)(kout + 32 + 8 * i) = (f32x4){o2[0], o2[1], o2[2], o2[3]}; *(f32x4*)(kout + 32 + 8 * i + 4) = (f32x4){o2[4], o2[5], o2[6], o2[7]};
        }
        asm volatile("" ::: "memory");
    }
}
__device__ __forceinline__ void v_fill(const bf16* zv, LAS bf16* vcol  , float* vout) {
#pragma unroll 1
    for (int i = 0; i < 8; ++i) {
        const v4u raw = *(const v4u*)(zv + 8 * i); float x[8]; unpack8(raw, x);
#pragma unroll
        for (int j = 0; j < 8; ++j) vcol[(8 * i + j) * VP] = (bf16)(__float_as_uint(x[j]) >> 16);
        if (vout) { *(f32x4*)(vout + 8 * i) = (f32x4){x[0], x[1], x[2], x[3]}; *(f32x4*)(vout + 8 * i + 4) = (f32x4){x[4], x[5], x[6], x[7]}; }
        asm volatile("" ::: "memory");
    }
}

__device__ __forceinline__ void kv_fill(Frame& F, const bf16* zk, const bf16* zv, int prow, LAS bf16* krow, LAS bf16* vcol, float* kout, float* vout) {
    const Args __attribute__((address_space(4)))& A = *F.a; const float* gk = A.in[17];
    v4u rk[8], rv[8];
#pragma unroll
    for (int i = 0; i < 8; ++i) { rk[i] = *(const v4u*)(zk + 8 * i); rv[i] = *(const v4u*)(zv + 8 * i); }
    float ss = 0.f;
#pragma unroll
    for (int i = 0; i < 8; ++i) { float x[8]; unpack8(rk[i], x);
#pragma unroll
        for (int j = 0; j < 8; ++j) ss += x[j] * x[j]; }
    const float rs = __builtin_amdgcn_rsqf(ss * (1.0f / 64.0f) + 1e-6f);
    const f32x4* tab = (const f32x4*)(F.rope + prow * 32);
#pragma unroll
    for (int i = 0; i < 4; ++i) {
        float x1[8], x2[8], o1[8], o2[8]; unpack8(rk[i], x1); unpack8(rk[4 + i], x2);
        const f32x4 t0 = tab[4 * i], t1 = tab[4 * i + 1], t2 = tab[4 * i + 2], t3 = tab[4 * i + 3];
        const float cs[16] = {t0[0], t0[1], t0[2], t0[3], t1[0], t1[1], t1[2], t1[3], t2[0], t2[1], t2[2], t2[3], t3[0], t3[1], t3[2], t3[3]};
        const f32x4 ga = *(const f32x4*)(gk + 8 * i), gb = *(const f32x4*)(gk + 8 * i + 4), gc = *(const f32x4*)(gk + 32 + 8 * i), gd = *(const f32x4*)(gk + 32 + 8 * i + 4);
        const float g1[8] = {ga[0], ga[1], ga[2], ga[3], gb[0], gb[1], gb[2], gb[3]}, g2[8] = {gc[0], gc[1], gc[2], gc[3], gd[0], gd[1], gd[2], gd[3]};
#pragma unroll
        for (int j = 0; j < 8; ++j) { const float a = x1[j] * rs * g1[j], b = x2[j] * rs * g2[j]; o1[j] = a * cs[2 * j] - b * cs[2 * j + 1]; o2[j] = b * cs[2 * j] + a * cs[2 * j + 1]; }
        *(LAS v4u*)(krow + 8 * i) = pack8(o1); *(LAS v4u*)(krow + 32 + 8 * i) = pack8(o2);
        if (kout) {
            *(f32x4*)(kout + 8 * i) = (f32x4){o1[0], o1[1], o1[2], o1[3]}; *(f32x4*)(kout + 8 * i + 4) = (f32x4){o1[4], o1[5], o1[6], o1[7]};
            *(f32x4*)(kout + 32 + 8 * i) = (f32x4){o2[0], o2[1], o2[2], o2[3]}; *(f32x4*)(kout + 32 + 8 * i + 4) = (f32x4){o2[4], o2[5], o2[6], o2[7]};
        }
        asm volatile("" ::: "memory");
    }
#pragma unroll
    for (int i = 0; i < 8; ++i) {
        const unsigned wv[4] = {rv[i].x, rv[i].y, rv[i].z, rv[i].w};
#pragma unroll
        for (int q = 0; q < 4; ++q) { vcol[(8 * i + 2 * q) * VP] = (bf16)(wv[q] & 0xffffu); vcol[(8 * i + 2 * q + 1) * VP] = (bf16)(wv[q] >> 16); }
        if (vout) { float x[8]; unpack8(rv[i], x); *(f32x4*)(vout + 8 * i) = (f32x4){x[0], x[1], x[2], x[3]}; *(f32x4*)(vout + 8 * i + 4) = (f32x4){x[4], x[5], x[6], x[7]}; }
    }
}

struct QRaw { v4u q0, q1; f32x4 t[4]; };
__device__ __forceinline__ QRaw q_load(Frame& F, size_t mrow, int hq, int prow) {
    const int fq = F.lane >> 4; QRaw r;
    const bf16* zq = F.Z + mrow * NIN + 1024 + 64 * hq + 8 * fq;
    r.q0 = *(const v4u*)zq; r.q1 = *(const v4u*)(zq + 32);
    const f32x4* tab = (const f32x4*)(F.rope + prow * 32 + 8 * fq);
#pragma unroll
    for (int i = 0; i < 4; ++i) r.t[i] = tab[i];
    return r;
}
__device__ __forceinline__ void attn_qblock(Frame& F, const QRaw& qr, const float (&gq1)[8], const float (&gq2)[8], const LAS bf16* Kl, const LAS bf16* Vl, LAS float* partp, size_t mrow, int tq, int tq_lo, int tq_hi, int hq, float sink_nat, int kb0, int jmin) {
    const int fq = F.lane >> 4;
    float x1[8], x2[8]; unpack8(qr.q0, x1); unpack8(qr.q1, x2);
    float ss = 0.f;
#pragma unroll
    for (int j = 0; j < 8; ++j) ss += x1[j] * x1[j] + x2[j] * x2[j];
    ss += __shfl_xor(ss, 16); ss += __shfl_xor(ss, 32);
    const float rs = (0.125f * 1.4426950408889634f) * __builtin_amdgcn_rsqf(ss * (1.0f / 64.0f) + 1e-6f);
#pragma unroll
    for (int j = 0; j < 8; ++j) { const float a = x1[j] * rs * gq1[j], b = x2[j] * rs * gq2[j]; const float cc = qr.t[j >> 1][2 * (j & 1)], sn = qr.t[j >> 1][2 * (j & 1) + 1]; x1[j] = a * cc - b * sn; x2[j] = b * cc + a * sn; }
    const bf16x8 Yq0 = as_bf16x8(pack8(x1)), Yq1 = as_bf16x8(pack8(x2));
    f32x4 S[10];
#pragma unroll
    for (int kk = 0; kk < 10; ++kk) {
        const LAS bf16* kp = Kl + (16 * (kb0 + kk) + (F.lane & 15)) * KP + 8 * fq;
        const bf16x8 X0 = *(const LAS bf16x8*)kp, X1 = *(const LAS bf16x8*)(kp + 32);
        f32x4 a = {0.f, 0.f, 0.f, 0.f};
        a = __builtin_amdgcn_mfma_f32_16x16x32_bf16(X0, Yq0, a, 0, 0, 0);
        a = __builtin_amdgcn_mfma_f32_16x16x32_bf16(X1, Yq1, a, 0, 0, 0);
        S[kk] = a;
    }
    const float sink = sink_nat * 1.4426950408889634f;
    float mx = sink;
#pragma unroll
    for (int kk = 0; kk < 10; ++kk) {
        const int jb = 16 * (kb0 + kk);
        if (jb > tq_hi && jb + 15 <= tq_lo + 128 && jb >= jmin) {
#pragma unroll
            for (int v = 0; v < 4; ++v) mx = fmaxf(mx, S[kk][v]);
        } else {
#pragma unroll
            for (int v = 0; v < 4; ++v) { const int j = jb + 4 * fq + v; const bool ok = (j > tq) && (j <= tq + 128) && (j >= jmin); S[kk][v] = ok ? S[kk][v] : -INFINITY; mx = fmaxf(mx, S[kk][v]); }
        }
    }
    mx = fmaxf(mx, __shfl_xor(mx, 16)); mx = fmaxf(mx, __shfl_xor(mx, 32));
    float sum = 0.f;
#pragma unroll
    for (int kk = 0; kk < 10; ++kk)
#pragma unroll
        for (int v = 0; v < 4; ++v) { const float p = __builtin_amdgcn_exp2f(S[kk][v] - mx); S[kk][v] = p; sum += p; }
    sum += __shfl_xor(sum, 16); sum += __shfl_xor(sum, 32);
    const float inv = __builtin_amdgcn_rcpf(sum + __builtin_amdgcn_exp2f(sink - mx));
    bf16x8 Yp[5];
#pragma unroll
    for (int i = 0; i < 5; ++i) { v4u w; w.x = cvt_pk_bf16(S[2 * i][0], S[2 * i][1]); w.y = cvt_pk_bf16(S[2 * i][2], S[2 * i][3]); w.z = cvt_pk_bf16(S[2 * i + 1][0], S[2 * i + 1][1]); w.w = cvt_pk_bf16(S[2 * i + 1][2], S[2 * i + 1][3]); Yp[i] = as_bf16x8(w); }
    float ssq = 0.f;
#pragma unroll
    for (int db = 0; db < 4; ++db) {
        f32x4 o = {0.f, 0.f, 0.f, 0.f};
#pragma unroll
        for (int i = 0; i < 5; ++i) {
            const LAS bf16* vp = Vl + (16 * db + (F.lane & 15)) * VP + 16 * (kb0 + 2 * i) + 4 * fq;
            const v2u lo = *(const LAS v2u*)vp, hi = *(const LAS v2u*)(vp + 16);
            v4u xw; xw.x = lo.x; xw.y = lo.y; xw.z = hi.x; xw.w = hi.y;
            o = __builtin_amdgcn_mfma_f32_16x16x32_bf16(as_bf16x8(xw), Yp[i], o, 0, 0, 0);
        }
        o = o * inv; ssq += (o[0] * o[0] + o[1] * o[1]) + (o[2] * o[2] + o[3] * o[3]);
        v2u ow; ow.x = cvt_pk_bf16(o[0], o[1]); ow.y = cvt_pk_bf16(o[2], o[3]);
        *(v2u*)(F.MIX + mrow * D + 512 + 64 * hq + 16 * db + 4 * fq) = ow;
    }
    ssq += __shfl_xor(ssq, 16); ssq += __shfl_xor(ssq, 32);
    if (fq == 0) *partp = ssq;
}

__device__ __forceinline__ void mix_prompt_B(Frame& F, int n, int c) {
    const __attribute__((address_space(4))) Args& A = *F.a;
    LAS bf16* Kl = (LAS bf16*)F.lds; LAS bf16* Vl = (LAS bf16*)(F.lds + 2 * 256 * KP * 2); LAS float* part = (LAS float*)(F.lds + OFF_PART);
    const size_t m0 = (size_t)n * SEQ + (size_t)c * 128; const int lane = F.lane, w = F.wave, tid = F.tid;
    {
        const int kv = tid >> 8, j = tid & 255;
        LAS bf16* krow = Kl + (kv * 256 + j) * KP; LAS bf16* vcol = Vl + kv * 64 * VP + j;
        if (c == 0 && j < 128) {
#pragma unroll
            for (int i = 0; i < 8; ++i) *(LAS v4u*)(krow + 8 * i) = (v4u){0u, 0u, 0u, 0u};
            for (int d = 0; d < 64; ++d) vcol[d * VP] = 0;
        } else {
            const size_t mk = m0 - 128 + j; const bool tail = (c == 15 && j >= 128);
            float* kout = tail ? F.out + OUT_PKW + (((size_t)n * 128 + (j - 128)) * 2 + kv) * 64 : nullptr;
            float* vout = tail ? F.out + OUT_PVW + (((size_t)n * 128 + (j - 128)) * 2 + kv) * 64 : nullptr;
            kv_fill(F, F.Z + mk * NIN + 1536 + 64 * kv, F.Z + mk * NIN + 1664 + 64 * kv, (c - 1) * 128 + j, krow, vcol, kout, vout);
        }
    }
    __syncthreads();
    {
        const int h = w, kv = h >> 2, fr = lane & 15, fq = lane >> 4;
        float gq1[8], gq2[8];
#pragma unroll
        for (int j = 0; j < 8; ++j) { gq1[j] = A.in[16][8 * fq + j]; gq2[j] = A.in[16][32 + 8 * fq + j]; }
        const float sink = A.in[18][h];
        QRaw cur = q_load(F, m0 + fr, h, c * 128 + fr);
#pragma unroll 1
        for (int qb = 0; qb < 8; ++qb) {
            const int tq = 16 * qb + fr, tn = (qb < 7) ? tq + 16 : tq;
            const QRaw nxt = q_load(F, m0 + tn, h, c * 128 + tn);
            attn_qblock(F, cur, gq1, gq2, Kl + kv * 256 * KP, Vl + kv * 64 * VP, part + tq * 8 + h, m0 + tq, tq, 16 * qb, 16 * qb + 15, h, sink, qb & ~1, c == 0 ? 128 : 0);
            cur = nxt;
        }
    }
    __syncthreads();
    finalize_rows<16>(F, m0, 512, A.in[20]);
}

__device__ __forceinline__ void mix_sample_A(Frame& F, int n) {
    const __attribute__((address_space(4))) Args& A = *F.a;
    LAS float* red = (LAS float*)(F.lds + OFF_RED);
    const size_t m0 = (size_t)MP + (size_t)n * 8; const int lane = F.lane, w = F.wave, tid = F.tid;
    {
        const int col = tid, h = col >> 6;
        float v[8];
#pragma unroll
        for (int s = 0; s < 8; ++s) v[s] = bf2f(F.Z[(m0 + s) * NIN + 512 + col]);
#pragma unroll
        for (int s = 0; s < 8; ++s) { const float a = wave_sum(v[s]), b = wave_sum(v[s] * v[s]); if (lane == 0) { red[w * 16 + s] = a; red[w * 16 + 8 + s] = b; } }
        __syncthreads();
        const float gc = A.in[12][col], bc = A.in[13][col];
#pragma unroll
        for (int s = 0; s < 8; ++s) {
            float a = 0.f, b = 0.f;
#pragma unroll
            for (int ww = 0; ww < 8; ++ww) { a += red[ww * 16 + s]; b += red[ww * 16 + 8 + s]; }
            const float mean = a * (1.0f / 512.0f), var = fmaxf(b * (1.0f / 512.0f) - mean * mean, 0.f);
            v[s] = (v[s] - mean) * (__builtin_amdgcn_rsqf(var + 1e-6f)) * gc + bc;
            F.out[OUT_SCV + ((size_t)n * 8 + s) * 512 + col] = v[s];
        }
        __syncthreads();
        float a[8];
#pragma unroll
        for (int t = 0; t < 8; ++t) {
            const float* wr = A.in[14] + ((size_t)(h * 128 + t)) * 128; float mixed = A.in[15][h * 128 + t];
#pragma unroll
            for (int s = 0; s < 8; ++s) if (s <= t) mixed += wr[s] * v[s];
            a[t] = bf2f(F.Z[(m0 + t) * NIN + col]) * mixed;
            const float q = wave_sum(a[t] * a[t]); if (lane == 0) red[w * 16 + t] = q;
        }
        __syncthreads();
        const float go = A.in[19][col];
#pragma unroll
        for (int t = 0; t < 8; ++t) {
            float q = 0.f;
#pragma unroll
            for (int ww = 0; ww < 8; ++ww) q += red[ww * 16 + t];
            const float rs = __builtin_amdgcn_rsqf(q * (1.0f / 512.0f) + 1e-6f);
            F.MIX[(m0 + t) * D + col] = (bf16)(cvt_pk_bf16(a[t] * rs * go, 0.f) & 0xffffu);
        }
    }
}

__device__ __forceinline__ void mix_sample_B(Frame& F, int n) {
    const __attribute__((address_space(4))) Args& A = *F.a;
    LAS bf16* Kl = (LAS bf16*)F.lds; LAS bf16* Vl = (LAS bf16*)(F.lds + 2 * 256 * KP * 2); LAS float* part = (LAS float*)(F.lds + OFF_PART);
    const size_t m0 = (size_t)MP + (size_t)n * 8; const int lane = F.lane, w = F.wave, tid = F.tid;
    {
        const int kv = tid >> 8, j = tid & 255;
        LAS bf16* krow = Kl + (kv * 256 + j) * KP; LAS bf16* vcol = Vl + kv * 64 * VP + j;
        if (j < 128) {
            const float* ck = A.in[4] + (((size_t)n * 128 + j) * 2 + kv) * 64; const float* cvp = A.in[5] + (((size_t)n * 128 + j) * 2 + kv) * 64;
            float* ko = (j >= 8) ? F.out + OUT_SKW + (((size_t)n * 128 + (j - 8)) * 2 + kv) * 64 : nullptr;
            float* vo = (j >= 8) ? F.out + OUT_SVW + (((size_t)n * 128 + (j - 8)) * 2 + kv) * 64 : nullptr;
#pragma unroll 2
            for (int i = 0; i < 8; ++i) {
                const f32x4 k0 = *(const f32x4*)(ck + 8 * i), k1 = *(const f32x4*)(ck + 8 * i + 4), v0 = *(const f32x4*)(cvp + 8 * i), v1 = *(const f32x4*)(cvp + 8 * i + 4);
                v4u kw; kw.x = cvt_pk_bf16(k0[0], k0[1]); kw.y = cvt_pk_bf16(k0[2], k0[3]); kw.z = cvt_pk_bf16(k1[0], k1[1]); kw.w = cvt_pk_bf16(k1[2], k1[3]);
                *(LAS v4u*)(krow + 8 * i) = kw;
                const unsigned va = cvt_pk_bf16(v0[0], v0[1]), vb = cvt_pk_bf16(v0[2], v0[3]), vc = cvt_pk_bf16(v1[0], v1[1]), vd = cvt_pk_bf16(v1[2], v1[3]);
                vcol[(8 * i + 0) * VP] = (bf16)(va & 0xffffu); vcol[(8 * i + 1) * VP] = (bf16)(va >> 16); vcol[(8 * i + 2) * VP] = (bf16)(vb & 0xffffu); vcol[(8 * i + 3) * VP] = (bf16)(vb >> 16);
                vcol[(8 * i + 4) * VP] = (bf16)(vc & 0xffffu); vcol[(8 * i + 5) * VP] = (bf16)(vc >> 16); vcol[(8 * i + 6) * VP] = (bf16)(vd & 0xffffu); vcol[(8 * i + 7) * VP] = (bf16)(vd >> 16);
                if (ko) { *(f32x4*)(ko + 8 * i) = k0; *(f32x4*)(ko + 8 * i + 4) = k1; *(f32x4*)(vo + 8 * i) = v0; *(f32x4*)(vo + 8 * i + 4) = v1; }
            }
        } else if (j >= 136 && j < 160) {
#pragma unroll
            for (int i = 0; i < 8; ++i) *(LAS v4u*)(krow + 8 * i) = (v4u){0u, 0u, 0u, 0u};
            for (int d = 0; d < 64; ++d) vcol[d * VP] = 0;
        }
    }
    if (w == 7) {
        const int task = lane >> 2, q = lane & 3, t = task & 7, kv2 = task >> 3; const size_t mk = m0 + t;
        const bf16* zk = F.Z + mk * NIN + 1536 + 64 * kv2 + 8 * q; const bf16* zv = F.Z + mk * NIN + 1664 + 64 * kv2 + 8 * q;
        const v4u k0 = *(const v4u*)zk, k1 = *(const v4u*)(zk + 32), v0 = *(const v4u*)zv, v1 = *(const v4u*)(zv + 32);
        const f32x4* tab = (const f32x4*)(F.rope + (2048 + t) * 32 + 8 * q); f32x4 tt[4];
#pragma unroll
        for (int i = 0; i < 4; ++i) tt[i] = tab[i];
        const float* gk = A.in[17]; float g1[8], g2[8];
#pragma unroll
        for (int j2 = 0; j2 < 8; ++j2) { g1[j2] = gk[8 * q + j2]; g2[j2] = gk[32 + 8 * q + j2]; }
        float x1[8], x2[8], o1[8], o2[8]; unpack8(k0, x1); unpack8(k1, x2);
        float ss = 0.f;
#pragma unroll
        for (int j2 = 0; j2 < 8; ++j2) ss += x1[j2] * x1[j2] + x2[j2] * x2[j2];
        ss += __shfl_xor(ss, 1); ss += __shfl_xor(ss, 2);
        const float rs = __builtin_amdgcn_rsqf(ss * (1.0f / 64.0f) + 1e-6f);
#pragma unroll
        for (int j2 = 0; j2 < 8; ++j2) { const float a = x1[j2] * rs * g1[j2], b = x2[j2] * rs * g2[j2]; const float cc = tt[j2 >> 1][2 * (j2 & 1)], sn = tt[j2 >> 1][2 * (j2 & 1) + 1]; o1[j2] = a * cc - b * sn; o2[j2] = b * cc + a * sn; }
        LAS bf16* krow = Kl + (kv2 * 256 + 128 + t) * KP;
        *(LAS v4u*)(krow + 8 * q) = pack8(o1); *(LAS v4u*)(krow + 32 + 8 * q) = pack8(o2);
        float* ko = F.out + OUT_SKW + (((size_t)n * 128 + (120 + t)) * 2 + kv2) * 64; float* vo = F.out + OUT_SVW + (((size_t)n * 128 + (120 + t)) * 2 + kv2) * 64;
        *(f32x4*)(ko + 8 * q) = (f32x4){o1[0], o1[1], o1[2], o1[3]}; *(f32x4*)(ko + 8 * q + 4) = (f32x4){o1[4], o1[5], o1[6], o1[7]};
        *(f32x4*)(ko + 32 + 8 * q) = (f32x4){o2[0], o2[1], o2[2], o2[3]}; *(f32x4*)(ko + 32 + 8 * q + 4) = (f32x4){o2[4], o2[5], o2[6], o2[7]};
        LAS bf16* vcol = Vl + kv2 * 64 * VP + 128 + t;
        float y1[8], y2[8]; unpack8(v0, y1); unpack8(v1, y2);
#pragma unroll
        for (int e = 0; e < 8; ++e) { vcol[(8 * q + e) * VP] = (bf16)(__float_as_uint(y1[e]) >> 16); vcol[(32 + 8 * q + e) * VP] = (bf16)(__float_as_uint(y2[e]) >> 16); }
        *(f32x4*)(vo + 8 * q) = (f32x4){y1[0], y1[1], y1[2], y1[3]}; *(f32x4*)(vo + 8 * q + 4) = (f32x4){y1[4], y1[5], y1[6], y1[7]};
        *(f32x4*)(vo + 32 + 8 * q) = (f32x4){y2[0], y2[1], y2[2], y2[3]}; *(f32x4*)(vo + 32 + 8 * q + 4) = (f32x4){y2[4], y2[5], y2[6], y2[7]};
    }
    __syncthreads();
    if (w < 4) {
        const int fr = lane & 15, fq = lane >> 4, hq = 2 * w + (fr >> 3), t = fr & 7, kv = w >> 1;
        float gq1[8], gq2[8];
#pragma unroll
        for (int j = 0; j < 8; ++j) { gq1[j] = A.in[16][8 * fq + j]; gq2[j] = A.in[16][32 + 8 * fq + j]; }
        const QRaw qr = q_load(F, m0 + t, hq, 2048 + t);
        attn_qblock(F, qr, gq1, gq2, Kl + kv * 256 * KP, Vl + kv * 64 * VP, part + t * 8 + hq, m0 + t, t, 0, 7, hq, A.in[18][hq], 0, 0);
    }
    __syncthreads();
    finalize_rows<1>(F, m0, 512, A.in[20]);
}

__device__ __forceinline__ void p4_mixer(Frame& F) {
    const int b = blockIdx.x, G = F.G;
#ifndef NO_A
    for (int it = b; it < 128; it += G) { __syncthreads(); mix_prompt_A(F, it >> 4, it & 15); }
#endif
    asm volatile("" ::: "memory");
#ifndef NO_B
    for (int it = b + ((128 - b + G * 64) / G) * 0; it < 256; it += G) { if (it >= 128) { __syncthreads(); mix_prompt_B(F, (it - 128) >> 4, (it - 128) & 15); } }
#endif
    asm volatile("" ::: "memory");
#ifndef NO_S
    for (int it = b; it < 128; it += G) { __syncthreads(); mix_sample_B(F, it); }
    asm volatile("" ::: "memory");
    for (int it = b; it < 256; it += G) { if (it >= 128) { __syncthreads(); mix_sample_A(F, it - 128); } }
#endif
}

#define XB_TMO      128
#define XB_XCNT(j)  (256  + 64 * (j))
#define XB_XSUB(j)  (1280 + 64 * (j))
#define XB_XGEN(j)  (2304 + 64 * (j))
#define XB_TOP      3328
#define XB_TOPGEN   3392
#define XCD_BAR_WORDS 3456
#define XB_SPIN_CAP (1u << 18)

__device__ __forceinline__ unsigned xb_ld(unsigned* p)              { return __hip_atomic_load(p, __ATOMIC_RELAXED, __HIP_MEMORY_SCOPE_AGENT); }
__device__ __forceinline__ unsigned xb_add(unsigned* p, unsigned v) { return __hip_atomic_fetch_add(p, v, __ATOMIC_RELAXED, __HIP_MEMORY_SCOPE_AGENT); }
__device__ __forceinline__ unsigned xb_xcc_id() { return (unsigned)__builtin_amdgcn_s_getreg((3 << 11) | 20) & 0xFu; }
#define XB_SPIN(cond, bar) do { unsigned _sp = 0; while (cond) { __builtin_amdgcn_s_sleep(1); \
    if ((++_sp & 255u) == 0u) { if (xb_ld(&(bar)[XB_TMO])) break; if (_sp > XB_SPIN_CAP) { atomicAdd(&(bar)[XB_TMO], 1u); break; } } } } while (0)

struct XcdBarrier {
    unsigned* bar; unsigned x;
    volatile LAS unsigned* st;
};

__device__ __forceinline__ XcdBarrier xcd_barrier_post(unsigned* bar, volatile LAS unsigned* st) {
    XcdBarrier b; b.bar = bar; b.x = xb_xcc_id(); b.st = st;
    if (threadIdx.x == 0) (void)xb_add(&bar[XB_XCNT(b.x)], 1u);
    return b;
}
__device__ __forceinline__ void xcd_barrier_complete(unsigned* bar, unsigned x, unsigned& nloc, unsigned& nx) {
    const unsigned G = gridDim.x * gridDim.y * gridDim.z;
    unsigned sum, cnt, mine, sp = 0u;
    for (;;) {
        sum = 0u; cnt = 0u; mine = 0u;
#pragma unroll
        for (unsigned j = 0; j < 16; ++j) { const unsigned c = xb_ld(&bar[XB_XCNT(j)]); sum += c; cnt += (c > 0u) ? 1u : 0u; mine = (j == x) ? c : mine; }
        if (sum == G) break;
        __builtin_amdgcn_s_sleep(1);
        if ((++sp & 255u) == 0u) { if (xb_ld(&bar[XB_TMO])) break; if (sp > XB_SPIN_CAP) { atomicAdd(&bar[XB_TMO], 1u); break; } }
    }
    nloc = mine > 0u ? mine : 1u; nx = cnt > 0u ? cnt : 1u;
}

__device__ __forceinline__ void xcd_barrier(const XcdBarrier& b) {
    asm volatile("s_waitcnt vmcnt(0)" ::: "memory");
    __syncthreads();
    if (threadIdx.x == 0) {
        unsigned* bar = b.bar;
        __builtin_amdgcn_s_waitcnt(0);
        unsigned nloc = b.st[0], nx = b.st[1];
        if (nloc == 0u) { xcd_barrier_complete(bar, b.x, nloc, nx); b.st[0] = nloc; b.st[1] = nx; }
        const unsigned old = xb_add(&bar[XB_XSUB(b.x)], 1u);
        const unsigned gen = old / nloc;
        if (old + 1u == (gen + 1u) * nloc) {
            __builtin_amdgcn_fence(__ATOMIC_RELEASE, "agent");
            asm volatile("s_waitcnt vmcnt(0)" ::: "memory");
            const unsigned og = xb_add(&bar[XB_TOP], 1u);
            const unsigned tg = og / nx;
            if (og + 1u == (tg + 1u) * nx) xb_add(&bar[XB_TOPGEN], 1u);
            else XB_SPIN(xb_ld(&bar[XB_TOPGEN]) == tg, bar);
            __builtin_amdgcn_fence(__ATOMIC_ACQUIRE, "agent");
            asm volatile("s_waitcnt vmcnt(0)" ::: "memory");
        } else {
            XB_SPIN(xb_ld(&bar[XB_TOPGEN]) == gen, bar);
            __builtin_amdgcn_fence(__ATOMIC_ACQUIRE, "agent");
            asm volatile("s_waitcnt vmcnt(0)" ::: "memory");
        }
    }
    __syncthreads();
}

template <class Elem>
__device__ __forceinline__ void gemm_small64(LAS unsigned char* lds, const bf16* A, const bf16* Bt, int K, int r0, int c0, const Elem& E) {
    int tid_ = threadIdx.x; asm volatile("" : "+v"(tid_));
    const int tid = tid_, lane = tid & 63, w = __builtin_amdgcn_readfirstlane(tid >> 6), fr = lane & 15, fq = lane >> 4;
    const int kw = K >> 3, k0 = w * kw;
    f32x4 acc[4][4];
#pragma unroll
    for (int i = 0; i < 4; ++i)
#pragma unroll
        for (int j = 0; j < 4; ++j) acc[i][j] = (f32x4){0.f, 0.f, 0.f, 0.f};
    const bf16* ap = A + (size_t)(r0 + fr) * K + k0 + 8 * fq;
    const bf16* bp = Bt + (size_t)(c0 + fr) * K + k0 + 8 * fq;
    const size_t s16 = (size_t)16 * K;
#pragma unroll 4
    for (int ks = 0; ks < kw; ks += 32) {
        bf16x8 a[4], b[4];
#pragma unroll
        for (int i = 0; i < 4; ++i) { a[i] = *(const bf16x8*)(ap + i * s16 + ks); b[i] = *(const bf16x8*)(bp + i * s16 + ks); }
#pragma unroll
        for (int rb = 0; rb < 4; ++rb)
#pragma unroll
            for (int cb = 0; cb < 4; ++cb) acc[rb][cb] = __builtin_amdgcn_mfma_f32_16x16x32_bf16(b[cb], a[rb], acc[rb][cb], 0, 0, 0);
    }
    LAS float* P = (LAS float*)lds;
#pragma unroll
    for (int rb = 0; rb < 4; ++rb)
#pragma unroll
        for (int cb = 0; cb < 4; ++cb) *(LAS f32x4*)(P + (w * 64 + rb * 16 + fr) * 68 + cb * 16 + 4 * fq) = acc[rb][cb];
    __syncthreads();
    const int row = tid >> 3, c8 = (tid & 7) * 8;
    f32x4 v0 = {0.f, 0.f, 0.f, 0.f}, v1 = {0.f, 0.f, 0.f, 0.f};
#pragma unroll
    for (int ww = 0; ww < 8; ++ww) { v0 += *(const LAS f32x4*)(P + (ww * 64 + row) * 68 + c8); v1 += *(const LAS f32x4*)(P + (ww * 64 + row) * 68 + c8 + 4); }
    float ss = E.elem8(r0 + row, c0 + c8, v0, v1);
    if (Elem::HAS_SS) { ss += __shfl_xor(ss, 1); ss += __shfl_xor(ss, 2); ss += __shfl_xor(ss, 4); if ((tid & 7) == 0) E.row_ss(r0 + row, c0 >> 6, ss); }
    __syncthreads();
}
struct ElemRes {
    static constexpr bool HAS_SS = true;
    bf16* XB; float* SS; float alpha;
    __device__ __forceinline__ float elem8(int r, int c, f32x4 a0, f32x4 a1) const {
        bf16* xp = XB + (size_t)r * D + c; float x[8]; unpack8(*(const v4u*)xp, x);
#pragma unroll
        for (int j = 0; j < 4; ++j) { x[j] += a0[j] * alpha; x[4 + j] += a1[j] * alpha; }
        *(v4u*)xp = pack8(x);
        float ss = 0.f;
#pragma unroll
        for (int j = 0; j < 8; ++j) ss += x[j] * x[j];
        return ss;
    }
    __device__ __forceinline__ void row_ss(int r, int slot, float ss) const { SS[(size_t)r * 16 + slot] = ss; }
};
struct ElemPle {
    static constexpr bool HAS_SS = false;
    const bf16* XB; const bf16* P; float* Y; const float* SS;
    __device__ __forceinline__ float elem8(int r, int c, f32x4 a0, f32x4 a1) const {
        const float rs = pg8::row_rs(SS, r); const size_t off = (size_t)r * D + c;
        float x[8], p[8]; unpack8(*(const v4u*)(XB + off), x); unpack8(*(const v4u*)(P + off), p); f32x4 o0, o1;
#pragma unroll
        for (int j = 0; j < 4; ++j) { o0[j] = x[j] + __builtin_amdgcn_rcpf(1.0f + __expf(-a0[j] * rs)) * p[j]; o1[j] = x[4 + j] + __builtin_amdgcn_rcpf(1.0f + __expf(-a1[j] * rs)) * p[4 + j]; }
        *(f32x4*)(Y + off) = o0; *(f32x4*)(Y + off + 4) = o1; return 0.f;
    }
    __device__ __forceinline__ void row_ss(int, int, float) const {}
};
struct ElemBf {
    static constexpr bool HAS_SS = false;
    bf16* P;
    __device__ __forceinline__ float elem8(int r, int c, f32x4 a0, f32x4 a1) const { float x[8] = {a0[0], a0[1], a0[2], a0[3], a1[0], a1[1], a1[2], a1[3]}; *(v4u*)(P + (size_t)r * D + c) = pack8(x); return 0.f; }
    __device__ __forceinline__ void row_ss(int, int, float) const {}
};
template <class Elem>
__device__ __forceinline__ void gemm_sample_rows(Frame& F, const bf16* A, const bf16* Bt, int K, const Elem& E) {
    for (int st = blockIdx.x; st < 256; st += F.G) gemm_small64<Elem>(F.lds, A, Bt, K, MP + 64 * (st >> 4), 64 * (st & 15), E);
}

__global__ void __launch_bounds__(NWAVES * 64, 2) fwd_megakernel(Args args) {
    extern __shared__ __attribute__((aligned(16))) unsigned char lds_raw[];
    cg::grid_group grid = cg::this_grid();
    Frame F;
    F.lds = (LAS unsigned char*)lds_raw; F.tid = threadIdx.x; F.lane = F.tid & 63; F.wave = __builtin_amdgcn_readfirstlane(F.tid >> 6); F.G = gridDim.x;
    const __attribute__((address_space(4))) Args* KA = (const __attribute__((address_space(4))) Args*)__builtin_amdgcn_kernarg_segment_ptr();
    F.a = KA; F.out = KA->out;
    unsigned char* ws = KA->ws;
    F.Z = (bf16*)(ws + WS_Z); F.MIX = (bf16*)(ws + WS_MIX); F.rope = (const f32x2*)(ws + WS_ROPE);
    bf16* XG = (bf16*)(ws + WS_XB); bf16* ACT = (bf16*)(ws + WS_ACT); bf16* PRJ = (bf16*)(ws + WS_PRJ); float* SS = (float*)(ws + WS_SS);
    const int lo = KA->ph_lo, hi = KA->ph_hi;
    const bool spread = (F.G == 256);
#ifndef PH_MASK
#define PH_MASK 0x1ff
#endif
#define IN(k) (((PH_MASK >> (k)) & 1) && lo <= (k) && (k) < hi)
    if (F.tid < 64) ((LAS unsigned*)(F.lds + OFF_MISC))[F.tid] = 0u;
    __syncthreads();
    const XcdBarrier bar = xcd_barrier_post((unsigned*)(ws + WS_CTL), (volatile LAS unsigned*)(F.lds + OFF_MISC));
    if (lo > 1000) grid.sync();
#define SEAM(k) do { if (IN(k) && IN((k) + 1)) xcd_barrier(bar); } while (0)
    if (IN(0)) { p0_prologue(F); } SEAM(0);
    if (IN(1)) {
        pg8::Gemm g{XG, (const bf16*)(ws + WS_W1T), MT, 2 * FF, D}; pg8::StaticOrder S; S.init(MT, 2 * FF, F.G, (int)blockIdx.x);
        pg8::EpiAct E{ACT, SS, FF};
        pg8::gemm_phase<pg8::EpiAct, pg8::StaticOrder, true, true>(F.lds, g, S, E);
        if (spread) {
            const int k = (int)blockIdx.x - 216; pg8::RangeOrder R{k >= 0 ? 2 * k : 0, k >= 0 ? 2 * k + 2 : 0};
            pg8::Gemm gp{(const bf16*)(ws + WS_PE), (const bf16*)(ws + WS_WPP), MP, D, DPLE}; pg8::EpiBf Ep{PRJ};
            pg8::gemm_phase<pg8::EpiBf, pg8::RangeOrder, true, true>(F.lds, gp, R, Ep);
        }
    } SEAM(1);
    if (IN(2)) {
        pg8::Gemm g{ACT, (const bf16*)(ws + WS_W1D), MP, D, FF}; pg8::StaticOrder S; S.init(MP, D, F.G, (int)blockIdx.x);
        pg8::EpiRes E{XG, SS, 0.5f};
        pg8::gemm_phase<pg8::EpiRes, pg8::StaticOrder, true, true>(F.lds, g, S, E);
        ElemRes Es{XG, SS, 0.5f};
        gemm_sample_rows<ElemRes>(F, ACT, (const bf16*)(ws + WS_W1D), FF, Es);
    } SEAM(2);
    if (IN(3)) {
        { pg8::Gemm g{XG, (const bf16*)(ws + WS_WIN), MT, NIN, D}; pg8::StaticOrder S; S.init(MT, NIN, F.G, (int)blockIdx.x);
          pg8::EpiZ E{F.Z, SS, NIN, 4};
          pg8::gemm_phase<pg8::EpiZ, pg8::StaticOrder, true, true>(F.lds, g, S, E); }
        if (spread) {
            const int k = (int)blockIdx.x - 220; const int f = k < 0 ? 0 : (k < 24 ? 160 + 3 * k : 232 + 2 * (k - 24)), n = k < 0 ? 0 : (k < 24 ? 3 : 2); pg8::RangeOrder R{f, f + n};
            pg8::Gemm gp{(const bf16*)(ws + WS_PE), (const bf16*)(ws + WS_WPP), MP, D, DPLE}; pg8::EpiBf Ep{PRJ};
            pg8::gemm_phase<pg8::EpiBf, pg8::RangeOrder, true, true>(F.lds, gp, R, Ep);
        }
    } SEAM(3);
    if (IN(4)) { p4_mixer(F); } SEAM(4);
    if (IN(5)) {
        pg8::Gemm g{F.MIX, (const bf16*)(ws + WS_WO), MP, D, D}; pg8::StaticOrder S; S.init(MP, D, F.G, (int)blockIdx.x);
        pg8::EpiRes E{XG, SS, 1.0f};
        pg8::gemm_phase<pg8::EpiRes, pg8::StaticOrder, true, true>(F.lds, g, S, E);
        ElemRes Es{XG, SS, 1.0f};
        gemm_sample_rows<ElemRes>(F, F.MIX, (const bf16*)(ws + WS_WO), D, Es);
    } SEAM(5);
    if (IN(6)) {
        pg8::Gemm g{XG, (const bf16*)(ws + WS_W2T), MT, 2 * FF, D}; pg8::StaticOrder S; S.init(MT, 2 * FF, F.G, (int)blockIdx.x);
        pg8::EpiAct E{ACT, SS, FF};
        pg8::gemm_phase<pg8::EpiAct, pg8::StaticOrder, true, true>(F.lds, g, S, E);
        if (spread) {
            const int k = (int)blockIdx.x - 216; pg8::RangeOrder R{k >= 0 ? 80 + 2 * k : 0, k >= 0 ? 80 + 2 * k + 2 : 0};
            pg8::Gemm gp{(const bf16*)(ws + WS_PE), (const bf16*)(ws + WS_WPP), MP, D, DPLE}; pg8::EpiBf Ep{PRJ};
            pg8::gemm_phase<pg8::EpiBf, pg8::RangeOrder, true, true>(F.lds, gp, R, Ep);
        }
    } SEAM(6);
    if (IN(7)) {
        pg8::Gemm g{ACT, (const bf16*)(ws + WS_W2D), MP, D, FF}; pg8::StaticOrder S; S.init(MP, D, F.G, (int)blockIdx.x);
        pg8::EpiRes E{XG, SS, 0.5f};
        pg8::gemm_phase<pg8::EpiRes, pg8::StaticOrder, true, true>(F.lds, g, S, E);
        ElemRes Es{XG, SS, 0.5f};
        gemm_sample_rows<ElemRes>(F, ACT, (const bf16*)(ws + WS_W2D), FF, Es);
    } SEAM(7);
    if (IN(8)) {
        pg8::Gemm g{(const bf16*)(ws + WS_PE), (const bf16*)(ws + WS_WPP), MP, D, DPLE}; pg8::StaticOrder S; S.init(MP, D, F.G, (int)blockIdx.x);
        pg8::EpiBf E{PRJ};
        if (!spread) pg8::gemm_phase<pg8::EpiBf, pg8::StaticOrder, true, true>(F.lds, g, S, E);
        ElemBf Es{PRJ};
        gemm_sample_rows<ElemBf>(F, (const bf16*)(ws + WS_PE), (const bf16*)(ws + WS_WPP), DPLE, Es);
        asm volatile("s_waitcnt vmcnt(0)" ::: "memory"); __syncthreads();
    }
    if (IN(8)) {
        pg8::Gemm g{XG, (const bf16*)(ws + WS_WPG), MP, D, D}; pg8::StaticOrder S; S.init(MP, D, F.G, (int)blockIdx.x);
        pg8::EpiPle E{XG, PRJ, F.out + OUT_Y, SS};
        pg8::gemm_phase<pg8::EpiPle, pg8::StaticOrder, true, true>(F.lds, g, S, E);
        ElemPle Es{XG, PRJ, F.out + OUT_Y, SS};
        gemm_sample_rows<ElemPle>(F, XG, (const bf16*)(ws + WS_WPG), D, Es);
    }
#undef IN
#undef SEAM
}

#ifndef MK_N_LAUNCHES
#define MK_N_LAUNCHES 1
#endif
extern "C" void kernel_launch(void* const* d_in, const int* in_sizes, int n_in, void* d_out, int out_size, void* d_ws, size_t ws_size, hipStream_t stream) {
    static int grid = 0;
    if (grid == 0) {
        if (n_in != 29 || out_size != (int)OUT_END || ws_size < WS_CTL + CTL_BYTES) { fprintf(stderr, "kernel_launch: unexpected shapes (n_in %d out %d ws %zu)\n", n_in, out_size, ws_size); grid = -1; return; }
        int dev = 0, cus = 0, per_cu = 0;
        hipGetDevice(&dev); hipDeviceGetAttribute(&cus, hipDeviceAttributeMultiprocessorCount, dev);
        if (hipFuncSetAttribute((const void*)fwd_megakernel, hipFuncAttributeMaxDynamicSharedMemorySize, LDS_BYTES) != hipSuccess) { fprintf(stderr, "kernel_launch: hipFuncSetAttribute failed\n"); grid = -1; return; }
        if (hipOccupancyMaxActiveBlocksPerMultiprocessor(&per_cu, (const void*)fwd_megakernel, NWAVES * 64, LDS_BYTES) != hipSuccess || per_cu < 1) { fprintf(stderr, "kernel_launch: occupancy query says %d\n", per_cu); per_cu = 1; }
        (void)hipGetLastError();
        grid = cus * per_cu;
        fprintf(stderr, "kernel_launch: grid %d (cus %d x %d)\n", grid, cus, per_cu);
    }
    if (grid < 0) return;
    Args a{};
    for (int i = 0; i < 29; ++i) a.in[i] = (const float*)d_in[i];
    a.out = (float*)d_out; a.ws = (unsigned char*)d_ws;
    if (hipMemsetAsync((char*)d_ws + WS_CTL, 0, CTL_BYTES, stream) != hipSuccess) { fprintf(stderr, "kernel_launch: memset failed\n"); return; }
    if (MK_N_LAUNCHES == 1) {
        a.ph_lo = 0; a.ph_hi = 9;
        void* kargs[] = {&a};
        const hipError_t e = hipLaunchCooperativeKernel((const void*)fwd_megakernel, dim3(grid), dim3(NWAVES * 64), kargs, LDS_BYTES, stream);
        if (e != hipSuccess) fprintf(stderr, "kernel_launch: cooperative launch failed: %s (grid %d)\n", hipGetErrorString(e), grid);
    } else {
        for (int p = 0; p < 9; ++p) { a.ph_lo = p; a.ph_hi = p + 1; hipLaunchKernelGGL(fwd_megakernel, dim3(grid), dim3(NWAVES * 64), LDS_BYTES, stream, a); }
    }
}
```

```cpp
#include <hip/hip_runtime.h>
#include <hip/hip_cooperative_groups.h>
#include <cstdio>
#include <cstdint>
#include <cmath>
namespace cg = cooperative_groups;
namespace pg8 {
#define PG8_LAS __attribute__((address_space(3)))
typedef unsigned short bf16_t;
typedef short bf16x8 __attribute__((ext_vector_type(8)));
typedef float f32x4 __attribute__((ext_vector_type(4)));
typedef unsigned u32x4 __attribute__((ext_vector_type(4)));
constexpr int BM = 256, BK = 64, HALF = 128, HTB = HALF * BK * 2  , STAGE_BYTES = 8 * HTB, NXCD = 8, WGM = 8;

__host__ __device__ __forceinline__ int lds_byte(int r, int c) { const int st = (r >> 4) * 2 + (c >> 5), rr = r & 15, cc = c & 31, ob = rr * 64 + cc * 2; return st * 1024 + (ob ^ (((ob >> 9) & 1) << 5)); }
__host__ __device__ __forceinline__ void stage_rc(int b, int& R, int& C) { const int st = b / 1024, sb = b % 1024, swz = sb ^ (((sb >> 9) & 1) << 5); R = (st >> 1) * 16 + swz / 64; C = (st & 1) * 32 + (swz % 64) / 2; }
__host__ __device__ __forceinline__ int perm32(int rho) { const int n = rho >> 4, i = rho & 15; return 8 * (i >> 2) + 4 * n + (i & 3); }

struct Unit { int pm, pn; };
struct Gemm { const bf16_t* A; const bf16_t* Bt; int M, N, K; };

struct StaticOrder {
    int nM, nN, nwg, G, c;
    __host__ __device__ void init(int M, int N, int G_, int c_) { nM = M / BM; nN = N / BM; nwg = nM * nN; G = G_; c = c_; }
    __host__ __device__ bool next(int i, Unit& u) const {
        const long L = (long)i * G + c; if (L >= nwg) return false;
        int wgid = (int)L; { const int q = nwg / NXCD, r = nwg % NXCD, xcd = wgid % NXCD, off = wgid / NXCD; wgid = (xcd < r ? xcd * (q + 1) : r * (q + 1) + (xcd - r) * q) + off; }
        const int nig = WGM * nN, gid = wgid / nig, fm = gid * WGM, gsz = (nM - fm) < WGM ? (nM - fm) : WGM;
        u.pm = fm + ((wgid % nig) % gsz); u.pn = (wgid % nig) / gsz; return true;
    }
    __device__ __forceinline__ void a_ready(const Unit&) const {}
    __device__ __forceinline__ void done(const Unit&) const {}
};

struct RangeOrder {
    int first, last;
    __host__ __device__ bool next(int i, Unit& u) const { const int idx = first + i; if (idx >= last) return false; u.pm = idx >> 2; u.pn = idx & 3; return true; }
    __device__ __forceinline__ void a_ready(const Unit&) const {}
    __device__ __forceinline__ void done(const Unit&) const {}
};

__device__ __forceinline__ unsigned cvt_pk_bf16(float lo, float hi) { unsigned r; asm volatile("v_cvt_pk_bf16_f32 %0, %1, %2" : "=v"(r) : "v"(lo), "v"(hi)); return r; }
typedef float f32x2 __attribute__((ext_vector_type(2)));
__device__ __forceinline__ float fast_rcp(float x) { return __builtin_amdgcn_rcpf(x); }
__device__ __forceinline__ float row_rs(const float* SS, int r) {
    const f32x4* p = (const f32x4*)(SS + (size_t)r * 16);
    const f32x4 a = p[0], b = p[1], c = p[2], d = p[3];
    const f32x4 s = (a + b) + (c + d);
    const float t = (s[0] + s[1]) + (s[2] + s[3]);
    return __builtin_amdgcn_rsqf(t * (1.0f / 1024.0f) + 1e-6f);
}
__device__ __forceinline__ void row_rs8(const float* SS, int row0, int fq, float (&rsv)[2][4]) {
    f32x4 q[2][4];
#pragma unroll
    for (int ai = 0; ai < 2; ++ai)
#pragma unroll
        for (int m = 0; m < 4; ++m) q[ai][m] = *(const f32x4*)(SS + (size_t)(row0 + ai * HALF + m * 16) * 16 + 4 * fq);
#pragma unroll
    for (int ai = 0; ai < 2; ++ai)
#pragma unroll
        for (int m = 0; m < 4; ++m) { float t = (q[ai][m][0] + q[ai][m][1]) + (q[ai][m][2] + q[ai][m][3]); t += __shfl_xor(t, 16); t += __shfl_xor(t, 32); rsv[ai][m] = __builtin_amdgcn_rsqf(t * (1.0f / 1024.0f) + 1e-6f); }
}
struct EpiAct {
    static constexpr bool PERM = true, AFTER_DRAIN = false;
    bf16_t* O; const float* SS; int ldo;
    __device__ __forceinline__ void operator()(const f32x4 (&acc)[2][2][4][2], const Unit& u, int wr, int wc, int fr, int fq) const {
        const int row0 = u.pm * BM + wr * 64 + fr, col0 = u.pn * HALF + wc * 32 + 8 * fq;
        float rsv[2][4]; row_rs8(SS, row0, fq, rsv);
#pragma unroll
        for (int ai = 0; ai < 2; ++ai)
#pragma unroll
            for (int m = 0; m < 4; ++m) {
                const int r = row0 + ai * HALF + m * 16; const float rs = rsv[ai][m], nrs = rs * -1.4426950408889634f, rs2 = rs * rs;
                float o[8];
#pragma unroll
                for (int n = 0; n < 2; ++n) {
                    const f32x4 t = acc[ai][0][m][n] * nrs, p = (acc[ai][0][m][n] * acc[ai][1][m][n]) * rs2;
#pragma unroll
                    for (int j = 0; j < 4; ++j) o[4 * n + j] = p[j] * fast_rcp(1.0f + __builtin_amdgcn_exp2f(t[j]));
                }
                u32x4 w; w.x = cvt_pk_bf16(o[0], o[1]); w.y = cvt_pk_bf16(o[2], o[3]); w.z = cvt_pk_bf16(o[4], o[5]); w.w = cvt_pk_bf16(o[6], o[7]);
                *(u32x4*)(O + (size_t)r * ldo + col0) = w;
            }
    }
};
struct EpiRes {
    static constexpr bool PERM = true, AFTER_DRAIN = false;
    bf16_t* XB; float* SS; float alpha;
    __device__ __forceinline__ void operator()(const f32x4 (&acc)[2][2][4][2], const Unit& u, int wr, int wc, int fr, int fq) const {
        const int row0 = u.pm * BM + wr * 64 + fr, col0 = u.pn * BM + wc * 32 + 8 * fq;
        u32x4 rb[2][4][2];
#pragma unroll
        for (int ai = 0; ai < 2; ++ai)
#pragma unroll
            for (int m = 0; m < 4; ++m) { const bf16_t* xq = XB + (size_t)(row0 + ai * HALF + m * 16) * 1024 + col0; rb[ai][m][0] = *(const u32x4*)xq; rb[ai][m][1] = *(const u32x4*)(xq + HALF); }
#pragma unroll
        for (int ai = 0; ai < 2; ++ai) {
#pragma unroll
            for (int m = 0; m < 4; ++m) {
                const int r = row0 + ai * HALF + m * 16;
                bf16_t* xp = XB + (size_t)r * 1024 + col0;
                const u32x4 b0 = rb[ai][m][0], b1 = rb[ai][m][1];
                float ss = 0.f;
#pragma unroll
                for (int bj = 0; bj < 2; ++bj) {
                    const u32x4 b = bj ? b1 : b0;
                    f32x4 v0, v1;
                    v0[0] = __uint_as_float(b.x << 16); v0[1] = __uint_as_float(b.x & 0xffff0000u); v0[2] = __uint_as_float(b.y << 16); v0[3] = __uint_as_float(b.y & 0xffff0000u);
                    v1[0] = __uint_as_float(b.z << 16); v1[1] = __uint_as_float(b.z & 0xffff0000u); v1[2] = __uint_as_float(b.w << 16); v1[3] = __uint_as_float(b.w & 0xffff0000u);
                    v0 += acc[ai][bj][m][0] * alpha; v1 += acc[ai][bj][m][1] * alpha;
                    ss += (v0[0] * v0[0] + v0[1] * v0[1]) + (v0[2] * v0[2] + v0[3] * v0[3]) + (v1[0] * v1[0] + v1[1] * v1[1]) + (v1[2] * v1[2] + v1[3] * v1[3]);
                    u32x4 w; w.x = cvt_pk_bf16(v0[0], v0[1]); w.y = cvt_pk_bf16(v0[2], v0[3]); w.z = cvt_pk_bf16(v1[0], v1[1]); w.w = cvt_pk_bf16(v1[2], v1[3]);
                    *(u32x4*)(xp + bj * HALF) = w;
                }
                ss += __shfl_xor(ss, 16); ss += __shfl_xor(ss, 32);
                if (fq == 0) SS[(size_t)r * 16 + u.pn * 4 + wc] = ss;
            }
        }
    }
};
struct EpiZ {
    static constexpr bool PERM = true, AFTER_DRAIN = false;
    bf16_t* O; const float* SS; int ldo, gelu_tiles; float* VS;
    __device__ __forceinline__ void operator()(const f32x4 (&acc)[2][2][4][2], const Unit& u, int wr, int wc, int fr, int fq) const {
        const int row0 = u.pm * BM + wr * 64 + fr, col0 = u.pn * BM + wc * 32 + 8 * fq;
        float rsv[2][4]; row_rs8(SS, row0, fq, rsv);
#pragma unroll
        for (int ai = 0; ai < 2; ++ai)
#pragma unroll
            for (int m = 0; m < 4; ++m) {
                const int r = row0 + ai * HALF + m * 16; const float rs = rsv[ai][m];
                float s1 = 0.f, s2 = 0.f;
#pragma unroll
                for (int bj = 0; bj < 2; ++bj) {
                    f32x4 a = acc[ai][bj][m][0] * rs, b = acc[ai][bj][m][1] * rs;
                    if (u.pn < gelu_tiles) {
#pragma unroll
                        for (int j = 0; j < 4; ++j) { const float ua = 1.5957691216057308f * a[j] * (1.0f + 0.044715f * a[j] * a[j]), ub = 1.5957691216057308f * b[j] * (1.0f + 0.044715f * b[j] * b[j]);
                            a[j] = a[j] * fast_rcp(1.0f + __expf(-ua)); b[j] = b[j] * fast_rcp(1.0f + __expf(-ub)); }
                    }
                    s1 += ((a[0] + a[1]) + (a[2] + a[3])) + ((b[0] + b[1]) + (b[2] + b[3]));
                    s2 += ((a[0] * a[0] + a[1] * a[1]) + (a[2] * a[2] + a[3] * a[3])) + ((b[0] * b[0] + b[1] * b[1]) + (b[2] * b[2] + b[3] * b[3]));
                    u32x4 w; w.x = cvt_pk_bf16(a[0], a[1]); w.y = cvt_pk_bf16(a[2], a[3]); w.z = cvt_pk_bf16(b[0], b[1]); w.w = cvt_pk_bf16(b[2], b[3]);
                    *(u32x4*)(O + (size_t)r * ldo + col0 + bj * HALF) = w;
                }
                if (u.pn == 2 || u.pn == 3) {
                    s1 += __shfl_xor(s1, 16); s1 += __shfl_xor(s1, 32); s2 += __shfl_xor(s2, 16); s2 += __shfl_xor(s2, 32);
                    if (fq == 0) *(f32x2*)(VS + (size_t)r * 16 + ((u.pn - 2) * 4 + wc) * 2) = (f32x2){s1, s2};
                }
            }
    }
};
struct EpiBf {
    static constexpr bool PERM = true, AFTER_DRAIN = false;
    bf16_t* P;
    __device__ __forceinline__ void operator()(const f32x4 (&acc)[2][2][4][2], const Unit& u, int wr, int wc, int fr, int fq) const {
        const int row0 = u.pm * BM + wr * 64 + fr, col0 = u.pn * BM + wc * 32 + 8 * fq;
#pragma unroll
        for (int ai = 0; ai < 2; ++ai)
#pragma unroll
            for (int m = 0; m < 4; ++m) {
                const int r = row0 + ai * HALF + m * 16;
#pragma unroll
                for (int bj = 0; bj < 2; ++bj) { const f32x4 a = acc[ai][bj][m][0], b = acc[ai][bj][m][1];
                    u32x4 w; w.x = cvt_pk_bf16(a[0], a[1]); w.y = cvt_pk_bf16(a[2], a[3]); w.z = cvt_pk_bf16(b[0], b[1]); w.w = cvt_pk_bf16(b[2], b[3]);
                    *(u32x4*)(P + (size_t)r * 1024 + col0 + bj * HALF) = w; }
            }
    }
};
struct EpiPle {
    static constexpr bool PERM = true, AFTER_DRAIN = false;
    const bf16_t* XB; const bf16_t* P; float* Y; const float* SS;
    __device__ __forceinline__ void operator()(const f32x4 (&acc)[2][2][4][2], const Unit& u, int wr, int wc, int fr, int fq) const {
        const int row0 = u.pm * BM + wr * 64 + fr, col0 = u.pn * BM + wc * 32 + 8 * fq;
        float rsv[2][4]; row_rs8(SS, row0, fq, rsv);
#pragma unroll
        for (int ai = 0; ai < 2; ++ai)
#pragma unroll
            for (int mp = 0; mp < 2; ++mp) {
                u32x4 xr[2][2], pr[2][2];
#pragma unroll
                for (int mm = 0; mm < 2; ++mm)
#pragma unroll
                    for (int bj = 0; bj < 2; ++bj) { const size_t off = (size_t)(row0 + ai * HALF + (2 * mp + mm) * 16) * 1024 + col0 + bj * HALF; xr[mm][bj] = *(const u32x4*)(XB + off); pr[mm][bj] = *(const u32x4*)(P + off); }
#pragma unroll
                for (int mm = 0; mm < 2; ++mm) {
                    const int m = 2 * mp + mm; const int r = row0 + ai * HALF + m * 16; const float nrs = rsv[ai][m] * -1.4426950408889634f;
#pragma unroll
                    for (int bj = 0; bj < 2; ++bj) {
                        const size_t off = (size_t)r * 1024 + col0 + bj * HALF;
                        const unsigned xw[4] = {xr[mm][bj].x, xr[mm][bj].y, xr[mm][bj].z, xr[mm][bj].w}, pw[4] = {pr[mm][bj].x, pr[mm][bj].y, pr[mm][bj].z, pr[mm][bj].w};
                        f32x4 o[2];
#pragma unroll
                        for (int q = 0; q < 4; ++q) {
                            const float t0 = acc[ai][bj][m][q >> 1][2 * (q & 1)] * nrs, t1 = acc[ai][bj][m][q >> 1][2 * (q & 1) + 1] * nrs;
                            o[q >> 1][2 * (q & 1)] = __uint_as_float(xw[q] << 16) + fast_rcp(1.0f + __builtin_amdgcn_exp2f(t0)) * __uint_as_float(pw[q] << 16);
                            o[q >> 1][2 * (q & 1) + 1] = __uint_as_float(xw[q] & 0xffff0000u) + fast_rcp(1.0f + __builtin_amdgcn_exp2f(t1)) * __uint_as_float(pw[q] & 0xffff0000u);
                        }
                        *(f32x4*)(Y + off) = o[0]; *(f32x4*)(Y + off + 4) = o[1];
                    }
                }
            }
    }
};

template <class Epi, class Sched, bool ALIGN_EPI = false, bool SP2 = false>
__device__ __forceinline__ void gemm_phase(PG8_LAS unsigned char* lds, const Gemm g, const Sched& S, const Epi& E) {
    int tid_ = threadIdx.x; asm volatile("" : "+v"(tid_));
    const int tid = tid_, wid = __builtin_amdgcn_readfirstlane(tid >> 6), lane = tid & 63, wr = wid >> 2, wc = wid & 3, fr = lane & 15, fq = lane >> 4;
    int K_ = g.K; asm volatile("" : "+s"(K_));
    const int K = K_, nt = K / BK;
    unsigned voffA[2], voffB[2];
#pragma unroll
    for (int i = 0; i < 2; ++i) { int R, C; stage_rc(tid * 16 + i * 8192, R, C); const int Rb = Epi::PERM ? ((R & ~31) + perm32(R & 31)) : R;
        voffA[i] = (unsigned)(R * K + C) * 2u; voffB[i] = (unsigned)(Rb * K + C) * 2u; }
    const size_t kstep = (size_t)(BK * 2);
    const size_t hstep = (size_t)HALF * K * 2;
    const size_t tstep = 2 * hstep;
    const unsigned ldsw = (unsigned)wid * 1024u;
    const int aoff = lds_byte(wr * 64 + fr, fq * 8), boff = lds_byte(wc * 32 + fr, fq * 8);
#define PG8_SA(b, h) (((b) * 2 + (h)) * HTB)
#define PG8_SB(b, h) ((4 + (b) * 2 + (h)) * HTB)
#define PG8_STAGE(bufoff, gbase, voff) do { _Pragma("unroll") for (int _i = 0; _i < 2; ++_i) \
        __builtin_amdgcn_global_load_lds((const unsigned*)((const char*)(gbase) + (voff)[_i]), (PG8_LAS unsigned*)(lds + (bufoff) + ldsw + _i * 8192), 16, 0, 0); } while (0)
#define PG8_LDA(dst, b, h) do { _Pragma("unroll") for (int m = 0; m < 4; ++m) _Pragma("unroll") for (int k = 0; k < 2; ++k) dst[m][k] = *(const PG8_LAS bf16x8*)(lds + PG8_SA(b, h) + aoff + m * 2048 + k * 1024); } while (0)
#define PG8_LDB(dst, b, h) do { _Pragma("unroll") for (int n = 0; n < 2; ++n) _Pragma("unroll") for (int k = 0; k < 2; ++k) dst[n][k] = *(const PG8_LAS bf16x8*)(lds + PG8_SB(b, h) + boff + n * 2048 + k * 1024); } while (0)
#define PG8_MMA(ai, bj, At, Bt) do { __builtin_amdgcn_s_setprio(1); _Pragma("unroll") for (int m = 0; m < 4; ++m) _Pragma("unroll") for (int n = 0; n < 2; ++n) _Pragma("unroll") for (int k = 0; k < 2; ++k) \
        acc[ai][bj][m][n] = __builtin_amdgcn_mfma_f32_16x16x32_bf16(Bt[n][k], At[m][k], acc[ai][bj][m][n], 0, 0, 0); __builtin_amdgcn_s_setprio(0); } while (0)
#define PG8_WAIT_V(n) asm volatile("s_waitcnt vmcnt(" #n ")" ::: "memory")
#define PG8_WAIT_L(n) asm volatile("s_waitcnt lgkmcnt(" #n ")" ::: "memory")
#define PG8_BAR __builtin_amdgcn_s_barrier()
#define PG8_SCHED __builtin_amdgcn_sched_barrier(0)
    Unit cur, nxt; int ui = 0;
    if (!S.next(0, cur)) return;
    f32x4 acc[2][2][4][2];
#pragma unroll
    for (int a = 0; a < 2; ++a)
#pragma unroll
        for (int b = 0; b < 2; ++b)
#pragma unroll
            for (int m = 0; m < 4; ++m)
#pragma unroll
                for (int n = 0; n < 2; ++n) acc[a][b][m][n] = (f32x4){0.f, 0.f, 0.f, 0.f};
    bf16x8 At[4][2], B0[2][2], B1[2][2];
    const char* cA = (const char*)g.A + (size_t)cur.pm * tstep; const char* cB = (const char*)g.Bt + (size_t)cur.pn * tstep;
    S.a_ready(cur);
    if constexpr (SP2) {
        PG8_STAGE(PG8_SB(0, 0), cB, voffB); PG8_STAGE(PG8_SB(0, 1), cB + hstep, voffB); PG8_STAGE(PG8_SA(0, 0), cA, voffA); PG8_STAGE(PG8_SA(0, 1), cA + hstep, voffA);
        if (wr == 1) PG8_BAR;
        PG8_WAIT_V(2); PG8_BAR;
        PG8_STAGE(PG8_SB(1, 0), cB + kstep, voffB); PG8_STAGE(PG8_SA(1, 0), cA + kstep, voffA); PG8_STAGE(PG8_SB(1, 1), cB + hstep + kstep, voffB);
        PG8_WAIT_V(6); PG8_BAR;
    } else {
        PG8_STAGE(PG8_SB(0, 0), cB, voffB); PG8_STAGE(PG8_SA(0, 0), cA, voffA); PG8_STAGE(PG8_SB(0, 1), cB + hstep, voffB); PG8_STAGE(PG8_SA(0, 1), cA + hstep, voffA);
        if (wr == 1) PG8_BAR;
        PG8_WAIT_V(4); PG8_BAR;
        PG8_STAGE(PG8_SB(1, 0), cB + kstep, voffB); PG8_STAGE(PG8_SA(1, 0), cA + kstep, voffA); PG8_STAGE(PG8_SB(1, 1), cB + hstep + kstep, voffB);
        PG8_WAIT_V(6); PG8_BAR;
    }
    for (;;) {
        const bool has_next = S.next(ui + 1, nxt);
        const char* nA = has_next ? (const char*)g.A + (size_t)nxt.pm * tstep : cA; const char* nB = has_next ? (const char*)g.Bt + (size_t)nxt.pn * tstep : cB;
        asm volatile(".p2align 8");
        for (int t = 0; t < nt; t += 2) {
            const bool last = (t == nt - 2);
            const char* a1 = cA + (size_t)(t + 1) * kstep;
            const char* a2 = last ? nA : cA + (size_t)(t + 2) * kstep; const char* b2 = last ? nB : cB + (size_t)(t + 2) * kstep;
            const char* a3 = a2 + kstep; const char* b3 = b2 + kstep;
            if (last && has_next) S.a_ready(nxt);
            if constexpr (SP2) {
            PG8_LDB(B0, 0, 0); PG8_LDB(B1, 0, 1); PG8_SCHED; PG8_LDA(At, 0, 0); PG8_STAGE(PG8_SA(1, 1), a1 + hstep, voffA);
            PG8_WAIT_V(8); PG8_WAIT_L(0); PG8_BAR; PG8_MMA(0, 0, At, B0); PG8_MMA(0, 1, At, B1); PG8_BAR; PG8_SCHED;
            PG8_LDA(At, 0, 1); PG8_STAGE(PG8_SB(0, 0), b2, voffB); PG8_STAGE(PG8_SB(0, 1), b2 + hstep, voffB); PG8_STAGE(PG8_SA(0, 0), a2, voffA);
            PG8_WAIT_V(8); PG8_WAIT_L(0); PG8_BAR; PG8_MMA(1, 0, At, B0); PG8_MMA(1, 1, At, B1); PG8_BAR; PG8_SCHED;
            PG8_LDB(B0, 1, 0); PG8_LDB(B1, 1, 1); PG8_SCHED; PG8_LDA(At, 1, 0); PG8_STAGE(PG8_SA(0, 1), a2 + hstep, voffA);
            PG8_WAIT_V(8); PG8_WAIT_L(0); PG8_BAR; PG8_MMA(0, 0, At, B0); PG8_MMA(0, 1, At, B1); PG8_BAR; PG8_SCHED;
            PG8_LDA(At, 1, 1); PG8_STAGE(PG8_SB(1, 0), b3, voffB); PG8_STAGE(PG8_SB(1, 1), b3 + hstep, voffB); PG8_STAGE(PG8_SA(1, 0), a3, voffA);
            PG8_WAIT_V(8); PG8_WAIT_L(0); PG8_BAR; PG8_MMA(1, 0, At, B0); PG8_MMA(1, 1, At, B1); PG8_BAR; PG8_SCHED;
            } else {
            PG8_LDB(B0, 0, 0); PG8_SCHED; PG8_LDA(At, 0, 0); PG8_STAGE(PG8_SA(1, 1), a1 + hstep, voffA);
            PG8_WAIT_L(8); PG8_BAR; PG8_WAIT_L(0); PG8_MMA(0, 0, At, B0); PG8_BAR; PG8_SCHED;
            PG8_LDB(B1, 0, 1); PG8_STAGE(PG8_SB(0, 0), b2, voffB);
            PG8_BAR; PG8_WAIT_L(0); PG8_MMA(0, 1, At, B1); PG8_BAR;
            PG8_LDA(At, 0, 1); PG8_STAGE(PG8_SA(0, 0), a2, voffA);
            PG8_BAR; PG8_WAIT_L(0); PG8_MMA(1, 0, At, B0); PG8_BAR; PG8_SCHED;
            PG8_STAGE(PG8_SB(0, 1), b2 + hstep, voffB);
            PG8_WAIT_V(6); PG8_BAR; PG8_MMA(1, 1, At, B1); PG8_BAR;
            PG8_LDB(B0, 1, 0); PG8_SCHED; PG8_LDA(At, 1, 0); PG8_STAGE(PG8_SA(0, 1), a2 + hstep, voffA);
            PG8_WAIT_L(8); PG8_BAR; PG8_WAIT_L(0); PG8_MMA(0, 0, At, B0); PG8_BAR; PG8_SCHED;
            PG8_LDB(B1, 1, 1); PG8_STAGE(PG8_SB(1, 0), b3, voffB);
            PG8_BAR; PG8_WAIT_L(0); PG8_MMA(0, 1, At, B1); PG8_BAR;
            PG8_LDA(At, 1, 1); PG8_STAGE(PG8_SA(1, 0), a3, voffA);
            PG8_BAR; PG8_WAIT_L(0); PG8_MMA(1, 0, At, B0); PG8_BAR; PG8_SCHED;
            PG8_STAGE(PG8_SB(1, 1), b3 + hstep, voffB);
            PG8_WAIT_V(6); PG8_BAR; PG8_MMA(1, 1, At, B1); PG8_BAR;
            }
        }
        if constexpr (ALIGN_EPI) { if (wr == 0) PG8_BAR; }
        if constexpr (!Epi::AFTER_DRAIN) { E(acc, cur, wr, wc, fr, fq); S.done(cur); }
        if (!has_next) break;
#pragma unroll
        for (int a = 0; a < 2; ++a)
#pragma unroll
            for (int b = 0; b < 2; ++b)
#pragma unroll
                for (int m = 0; m < 4; ++m)
#pragma unroll
                    for (int n = 0; n < 2; ++n) acc[a][b][m][n] = (f32x4){0.f, 0.f, 0.f, 0.f};
        cur = nxt; cA = nA; cB = nB; ++ui;
        if constexpr (ALIGN_EPI) { if (wr == 1) PG8_BAR; }
    }
    PG8_WAIT_V(0);
    if constexpr (!ALIGN_EPI) { if (wr == 0) PG8_BAR; }
    PG8_BAR;
    if constexpr (Epi::AFTER_DRAIN) { E.fused(acc, cur, wr, wc, fr, fq, lds, wid, lane); S.done(cur); }
#undef PG8_SA
#undef PG8_SB
#undef PG8_STAGE
#undef PG8_LDA
#undef PG8_LDB
#undef PG8_MMA
#undef PG8_WAIT_V
#undef PG8_WAIT_L
#undef PG8_BAR
#undef PG8_SCHED
}
}
constexpr int NWAVES = 8;
constexpr int MP = 16384, MS = 1024, MT = MP + MS;
constexpr int D = 1024, FF = 2816, NIN = 1792, DPLE = 256, SEQ = 2048, PAST = 16384;
constexpr int ROPE_ROWS = 2048 + 8;
constexpr size_t OUT_Y = 0, OUT_PKW = 17825792, OUT_PVW = 17956864, OUT_PCV = 18087936, OUT_SKW = 18612224, OUT_SVW = 20709376, OUT_SCV = 22806528, OUT_END = 23330816;
constexpr size_t WS_W1T = 0, WS_W1D = WS_W1T + 11534336, WS_WIN = WS_W1D + 5767168, WS_WO = WS_WIN + 3670016, WS_W2T = WS_WO + 2097152, WS_W2D = WS_W2T + 11534336,
                 WS_WPG = WS_W2D + 5767168, WS_WPP = WS_WPG + 2097152, WS_R = WS_WPP + 524288;
constexpr size_t WS_ACT = WS_R, WS_Z = WS_R, WS_MIX = WS_R + (size_t)MT * NIN * 2;
constexpr size_t WS_PRJ = WS_R + (size_t)MT * FF * 2, WS_XB = WS_PRJ + (size_t)MT * D * 2, WS_SS = WS_XB + (size_t)MT * D * 2, WS_PE = WS_SS + (size_t)MT * 16 * 4,
                 WS_ROPE = WS_PE + (size_t)MT * DPLE * 2, WS_END = WS_ROPE + (size_t)ROPE_ROWS * 32 * 8;
constexpr int XCD_BAR_WORDS_C = 3456;
constexpr size_t WS_CTL = WS_END, CTL_BYTES = 16384, WS_VS = WS_CTL + CTL_BYTES, WS_WSB = WS_VS + (size_t)MT * 16 * 4, WS_TOP = WS_WSB + (size_t)8 * 128 * 128 * 2;
static_assert(WS_MIX + (size_t)MT * D * 2 <= WS_PRJ && WS_CTL % 256 == 0 && WS_TOP <= 268435456 && XCD_BAR_WORDS_C * 4 <= CTL_BYTES, "d_ws map");
constexpr int LDS_BYTES = 155648, OFF_MISC = LDS_BYTES - 256;

#define LAS __attribute__((address_space(3)))
typedef unsigned short bf16;
typedef unsigned v4u __attribute__((ext_vector_type(4)));
typedef unsigned v2u __attribute__((ext_vector_type(2)));
typedef float f32x4 __attribute__((ext_vector_type(4)));
typedef float f32x2 __attribute__((ext_vector_type(2)));
typedef short bf16x8 __attribute__((ext_vector_type(8)));
typedef __bf16 bf16x2_t __attribute__((ext_vector_type(2)));
__device__ __forceinline__ unsigned cvt_pk_bf16(float lo, float hi) { const f32x2 v = {lo, hi}; const bf16x2_t b = __builtin_convertvector(v, bf16x2_t); return __builtin_bit_cast(unsigned, b); }

struct Args {
    const float* in[29]; float* out; unsigned char* ws; int ph_lo, ph_hi;
};

struct Frame {
    LAS unsigned char* lds; int tid, lane, wave, G;
    const __attribute__((address_space(4))) Args* a; float* out;
    bf16 *Z, *MIX; const f32x2* rope;
};

__device__ __forceinline__ float wave_sum(float v) {
#pragma unroll
    for (int o = 1; o < 64; o <<= 1) v += __shfl_xor(v, o);
    return v;
}
__device__ __forceinline__ float bf2f(unsigned short h) { return __uint_as_float((unsigned)h << 16); }
__device__ __forceinline__ void unpack2(unsigned w, float& lo, float& hi) { lo = __uint_as_float(w << 16); hi = __uint_as_float(w & 0xffff0000u); }
__device__ __forceinline__ void unpack8(const v4u w, float* f) { unpack2(w.x, f[0], f[1]); unpack2(w.y, f[2], f[3]); unpack2(w.z, f[4], f[5]); unpack2(w.w, f[6], f[7]); }
__device__ __forceinline__ v4u pack8(const float* f) { v4u w; w.x = cvt_pk_bf16(f[0], f[1]); w.y = cvt_pk_bf16(f[2], f[3]); w.z = cvt_pk_bf16(f[4], f[5]); w.w = cvt_pk_bf16(f[6], f[7]); return w; }
__device__ __forceinline__ bf16x8 as_bf16x8(const v4u w) { return __builtin_bit_cast(bf16x8, w); }
__device__ __forceinline__ float gelu_tanh(float x) {
    const float u = 1.5957691216057308f * x * (1.0f + 0.044715f * x * x);
    return x * __builtin_amdgcn_rcpf(1.0f + __expf(-u));
}

struct TItem { const float* W; const float* gk; bf16* WT; int K, N, mode, item; };
struct TRegs { f32x4 v[8]; };
__device__ __forceinline__ TRegs t_load(const TItem& t, int lane) {
    const int nblk = t.N / 32, kb = t.item / nblk, nb = t.item % nblk, k0 = 64 * kb, n0 = 32 * nb; TRegs r;
    const float* p = t.W + (size_t)(k0 + (lane >> 3)) * t.N + n0 + 4 * (lane & 7);
#pragma unroll
    for (int i = 0; i < 8; ++i) r.v[i] = *(const f32x4*)(p + (size_t)(8 * i) * t.N);
    if (t.gk) {
#pragma unroll
        for (int i = 0; i < 8; ++i) r.v[i] = r.v[i] * t.gk[k0 + (lane >> 3) + 8 * i];
    }
    return r;
}
__device__ __forceinline__ void t_store(const TItem& t, const TRegs& r, LAS float* scr, int lane) {
    const int nblk = t.N / 32, kb = t.item / nblk, nb = t.item % nblk, k0 = 64 * kb, n0 = 32 * nb;
    const int rbase = (t.mode == 0) ? n0 : (((n0 >> 7) << 8) + (n0 & 127) + (t.mode == 2 ? 128 : 0));
#pragma unroll
    for (int i = 0; i < 8; ++i) { LAS float* d = scr + ((lane >> 3) + 8 * i) * 33 + 4 * (lane & 7); d[0] = r.v[i][0]; d[1] = r.v[i][1]; d[2] = r.v[i][2]; d[3] = r.v[i][3]; }
    asm volatile("s_waitcnt lgkmcnt(0)" ::: "memory");
    const int c = lane & 7;
#pragma unroll
    for (int j = 0; j < 4; ++j) { const int n = (lane >> 3) + 8 * j; const LAS float* s = scr + (8 * c) * 33 + n;
        v4u o; o.x = cvt_pk_bf16(s[0 * 33], s[1 * 33]); o.y = cvt_pk_bf16(s[2 * 33], s[3 * 33]); o.z = cvt_pk_bf16(s[4 * 33], s[5 * 33]); o.w = cvt_pk_bf16(s[6 * 33], s[7 * 33]);
        *(v4u*)(t.WT + (size_t)(rbase + n) * t.K + k0 + 8 * c) = o; }
    asm volatile("s_waitcnt lgkmcnt(0)" ::: "memory");
}
__device__ __forceinline__ TItem t_decode(Frame& F, int it) {
    const __attribute__((address_space(4))) Args& A = *F.a; unsigned char* ws = A.ws;
    constexpr int I_FU = (D / 64) * (FF / 32), I_IN = (D / 64) * (NIN / 32), I_SQ = (D / 64) * (D / 32);
    TItem t; int r = it;
    if (r < I_FU) { t = TItem{A.in[7], A.in[6], (bf16*)(ws + WS_W1T), D, FF, 1, r}; return t; } r -= I_FU;
    if (r < I_FU) { t = TItem{A.in[8], A.in[6], (bf16*)(ws + WS_W1T), D, FF, 2, r}; return t; } r -= I_FU;
    if (r < I_FU) { t = TItem{A.in[9], nullptr, (bf16*)(ws + WS_W1D), FF, D, 0, r}; return t; } r -= I_FU;
    if (r < I_FU) { t = TItem{A.in[23], A.in[22], (bf16*)(ws + WS_W2T), D, FF, 1, r}; return t; } r -= I_FU;
    if (r < I_FU) { t = TItem{A.in[24], A.in[22], (bf16*)(ws + WS_W2T), D, FF, 2, r}; return t; } r -= I_FU;
    if (r < I_FU) { t = TItem{A.in[25], nullptr, (bf16*)(ws + WS_W2D), FF, D, 0, r}; return t; } r -= I_FU;
    if (r < I_IN) { t = TItem{A.in[11], A.in[10], (bf16*)(ws + WS_WIN), D, NIN, 0, r}; return t; } r -= I_IN;
    if (r < I_SQ) { t = TItem{A.in[21], nullptr, (bf16*)(ws + WS_WO), D, D, 0, r}; return t; } r -= I_SQ;
    if (r < I_SQ) { t = TItem{A.in[27], A.in[26], (bf16*)(ws + WS_WPG), D, D, 0, r}; return t; } r -= I_SQ;
    t = TItem{A.in[28], nullptr, (bf16*)(ws + WS_WPP), DPLE, D, 0, r}; return t;
}
__device__ __forceinline__ void p0_prologue(Frame& F) {
    const __attribute__((address_space(4))) Args& A = *F.a; unsigned char* ws = A.ws;
    LAS float* scr = (LAS float*)(F.lds + F.wave * 16384);
    const int gw = blockIdx.x * NWAVES + F.wave, NGW = F.G * NWAVES;
    constexpr int I_FU = (D / 64) * (FF / 32), I_FD = (FF / 64) * (D / 32), I_IN = (D / 64) * (NIN / 32), I_SQ = (D / 64) * (D / 32), I_PP = (DPLE / 64) * (D / 32);
    constexpr int NITEMS = 6 * I_FU + I_IN + 2 * I_SQ + I_PP;
    static_assert(I_FU == I_FD, "");
    {
        TItem t0 = t_decode(F, gw < NITEMS ? gw : 0), t1 = t_decode(F, gw + NGW < NITEMS ? gw + NGW : 0);
        TRegs r0 = t_load(t0, F.lane), r1 = t_load(t1, F.lane);
#pragma unroll 1
        for (int it = gw; it < NITEMS; it += 2 * NGW) {
            const int n0 = it + 2 * NGW, n1 = it + 3 * NGW;
            const TItem u0 = t_decode(F, n0 < NITEMS ? n0 : 0), u1 = t_decode(F, n1 < NITEMS ? n1 : 0);
            const TRegs q0 = t_load(u0, F.lane), q1 = t_load(u1, F.lane);
            t_store(t0, r0, scr, F.lane);
            if (it + NGW < NITEMS) t_store(t1, r1, scr, F.lane);
            t0 = u0; t1 = u1; r0 = q0; r1 = q1;
        }
    }
    bf16* XB = (bf16*)(ws + WS_XB); float* SS = (float*)(ws + WS_SS); bf16* PE = (bf16*)(ws + WS_PE);
#pragma unroll 1
    for (int m0 = gw; m0 < MT; m0 += 2 * NGW) {
        f32x4 v[2][4], pv[2]; int mm[2];
#pragma unroll
        for (int q = 0; q < 2; ++q) {
            const int m = (m0 + q * NGW < MT) ? m0 + q * NGW : m0; mm[q] = m;
            const float* xrow = (m < MP) ? A.in[0] + (size_t)m * D : A.in[1] + (size_t)(m - MP) * D;
            const float* prow = (m < MP) ? A.in[2] + (size_t)m * DPLE : A.in[3] + (size_t)(m - MP) * DPLE;
#pragma unroll
            for (int j = 0; j < 4; ++j) v[q][j] = *((const f32x4*)xrow + F.lane + 64 * j);
            pv[q] = *((const f32x4*)prow + F.lane);
        }
#pragma unroll
        for (int q = 0; q < 2; ++q) {
            const int m = mm[q]; float s = 0.f;
#pragma unroll
            for (int j = 0; j < 4; ++j) s += (v[q][j][0] * v[q][j][0] + v[q][j][1] * v[q][j][1]) + (v[q][j][2] * v[q][j][2] + v[q][j][3] * v[q][j][3]);
            s = wave_sum(s);
            v2u* o8 = (v2u*)(XB + (size_t)m * D) + F.lane;
#pragma unroll
            for (int j = 0; j < 4; ++j) { v2u w; w.x = cvt_pk_bf16(v[q][j][0], v[q][j][1]); w.y = cvt_pk_bf16(v[q][j][2], v[q][j][3]); o8[64 * j] = w; }
            if (F.lane < 16) SS[(size_t)m * 16 + F.lane] = (F.lane == 0) ? s : 0.f;
            v2u w; w.x = cvt_pk_bf16(pv[q][0], pv[q][1]); w.y = cvt_pk_bf16(pv[q][2], pv[q][3]);
            *((v2u*)(PE + (size_t)m * DPLE) + F.lane) = w;
        }
    }
    {
        bf16* WSB = (bf16*)(ws + WS_WSB); const float* wsrc = A.in[14];
        for (int e = blockIdx.x * (NWAVES * 64) + F.tid; e < 8 * 128 * 128 / 2; e += F.G * NWAVES * 64) {
            const int t = (e >> 6) & 127, s0 = 2 * (e & 63); const f32x2 v = *(const f32x2*)(wsrc + 2 * e);
            *(unsigned*)(WSB + 2 * e) = cvt_pk_bf16(s0 <= t ? v[0] : 0.f, s0 + 1 <= t ? v[1] : 0.f);
        }
    }
    f32x2* rope = (f32x2*)(ws + WS_ROPE);
    for (int e = blockIdx.x * (NWAVES * 64) + F.tid; e < ROPE_ROWS * 32; e += F.G * NWAVES * 64) {
        const int pr = e >> 5, i = e & 31; const int pos = pr < 2048 ? pr : PAST + (pr - 2048);
        const double inv = (double)exp2f(-(float)i * (13.287712379549449f / 32.0f));
        double t = (double)pos * inv * 0.15915494309189535; t -= floor(t);
        const float f = (float)t;
        rope[e] = (f32x2){__builtin_amdgcn_cosf(f), __builtin_amdgcn_sinf(f)};
    }
}

constexpr int VT_A = 136;
constexpr int KP = 72, VP = 264;
constexpr int LDS_PART = 141312 + 4096 - 4096;
constexpr int OFF_PART = 141312, OFF_RED = OFF_PART + 4096, OFF_STAT = OFF_RED + 1024;
static_assert(512 * VT_A * 2 <= OFF_PART && 2 * 256 * KP * 2 + 2 * 64 * VP * 2 <= OFF_PART && OFF_STAT + 1024 <= OFF_MISC, "mixer LDS map");

template <int PW>
__device__ __forceinline__ void finalize_rows(Frame& F, size_t m0, int coloff, const float* g) {
    const LAS float* part = (const LAS float*)(F.lds + OFF_PART);
    float gv[8];
#pragma unroll
    for (int j = 0; j < 8; ++j) gv[j] = g[8 * F.lane + j];
    constexpr int BATCH = PW < 8 ? PW : 8;
#pragma unroll 1
    for (int i0 = 0; i0 < PW; i0 += BATCH) {
        v4u raw[BATCH];
#pragma unroll
        for (int i = 0; i < BATCH; ++i) raw[i] = *(const v4u*)(F.MIX + (m0 + F.wave * PW + i0 + i) * D + coloff + 8 * F.lane);
#pragma unroll
        for (int i = 0; i < BATCH; ++i) {
            const int tt = F.wave * PW + i0 + i;
            const f32x4 p0 = *(const LAS f32x4*)(part + tt * 8), p1 = *(const LAS f32x4*)(part + tt * 8 + 4);
            const float tot = ((p0[0] + p0[1]) + (p0[2] + p0[3])) + ((p1[0] + p1[1]) + (p1[2] + p1[3]));
            const float rs = __builtin_amdgcn_rsqf(tot * (1.0f / 512.0f) + 1e-6f);
            float x[8]; unpack8(raw[i], x);
#pragma unroll
            for (int j = 0; j < 8; ++j) x[j] = x[j] * rs * gv[j];
            *(v4u*)(F.MIX + (m0 + tt) * D + coloff + 8 * F.lane) = pack8(x);
        }
    }
}

__device__ __forceinline__ void mix_prompt_A(Frame& F, int n, int c) {
    const __attribute__((address_space(4))) Args& A = *F.a;
    LAS bf16* Vt = (LAS bf16*)F.lds; LAS float* part = (LAS float*)(F.lds + OFF_PART); LAS float* stat = (LAS float*)(F.lds + OFF_STAT);
    const size_t m0 = (size_t)n * SEQ + (size_t)c * 128; const int lane = F.lane, w = F.wave, tid = F.tid;
    const int cp = tid & 255, th = tid >> 8, c0 = 2 * cp;
    const float g0 = A.in[12][c0], g1 = A.in[12][c0 + 1], b0 = A.in[13][c0], b1 = A.in[13][c0 + 1];
    const bf16* zc = F.Z + (m0 + 64 * th) * NIN + 512 + c0;
    float* cv = F.out + OUT_PCV + ((size_t)n * 128 + 64 * th) * 512 + c0;
    unsigned hvall[64];
#pragma unroll
    for (int j = 0; j < 32; ++j) hvall[j] = *(const unsigned*)(zc + (size_t)j * NIN);
    if (tid < 128) {
        const f32x4* p = (const f32x4*)((const float*)(A.ws + WS_VS) + (m0 + tid) * 16);
        const f32x4 a = p[0], b = p[1], c4 = p[2], d = p[3];
        const float S1 = ((a[0] + a[2]) + (b[0] + b[2])) + ((c4[0] + c4[2]) + (d[0] + d[2])), S2 = ((a[1] + a[3]) + (b[1] + b[3])) + ((c4[1] + c4[3]) + (d[1] + d[3]));
        const float mean = S1 * (1.0f / 512.0f), var = fmaxf(S2 * (1.0f / 512.0f) - mean * mean, 0.f);
        stat[2 * tid] = mean; stat[2 * tid + 1] = __builtin_amdgcn_rsqf(var + 1e-6f);
    }
    __syncthreads();
    {
#pragma unroll
        for (int j = 32; j < 64; ++j) hvall[j] = *(const unsigned*)(zc + (size_t)j * NIN);
#pragma unroll
        for (int g32 = 0; g32 < 2; ++g32) {
            const unsigned* hv = hvall + 32 * g32;
#pragma unroll
            for (int q = 0; q < 4; ++q) {
                float y0[8], y1[8];
#pragma unroll
                for (int j = 0; j < 8; ++j) { const int tt = 64 * th + 32 * g32 + 8 * q + j; const f32x2 st = *(const LAS f32x2*)(stat + 2 * tt); float lo, hi; unpack2(hv[8 * q + j], lo, hi);
                    y0[j] = (lo - st.x) * st.y * g0 + b0; y1[j] = (hi - st.x) * st.y * g1 + b1; }
                if (c == 15) {
#pragma unroll
                    for (int j = 0; j < 8; ++j) *(f32x2*)(cv + (size_t)(32 * g32 + 8 * q + j) * 512) = (f32x2){y0[j], y1[j]};
                }
                *(LAS v4u*)(Vt + c0 * VT_A + 64 * th + 32 * g32 + 8 * q) = pack8(y0);
                *(LAS v4u*)(Vt + (c0 + 1) * VT_A + 64 * th + 32 * g32 + 8 * q) = pack8(y1);
            }
        }
    }
    __syncthreads();
    {
        const int h = w, fr = lane & 15, fq = lane >> 4;
        const bf16* wbase = (const bf16*)(A.ws + WS_WSB) + (size_t)h * 128 * 128 + 8 * fq; const float* bsb = A.in[15] + h * 128;
#pragma unroll
        for (int half = 0; half < 4; ++half) {
            v4u wy[2][4]; v2u ur[2][4]; float bias[2];
#pragma unroll
            for (int q = 0; q < 2; ++q) {
                const int tb = 2 * half + q, t = tb * 16 + fr, nks = tb / 2 + 1;
#pragma unroll
                for (int ks = 0; ks < 4; ++ks) if (ks < nks) wy[q][ks] = *(const v4u*)(wbase + (size_t)t * 128 + 32 * ks);
#pragma unroll
                for (int db = 0; db < 4; ++db) ur[q][db] = *(const v2u*)(F.Z + (m0 + t) * NIN + 64 * h + 16 * db + 4 * fq);
                bias[q] = bsb[t];
            }
#pragma unroll
            for (int q = 0; q < 2; ++q) {
                const int tb = 2 * half + q, t = tb * 16 + fr, nks = tb / 2 + 1;
                bf16x8 Y[4];
#pragma unroll
                for (int ks = 0; ks < 4; ++ks) if (ks < nks) Y[ks] = as_bf16x8(wy[q][ks]);
                float ssq = 0.f;
#pragma unroll
                for (int db = 0; db < 4; ++db) {
                    f32x4 acc = {0.f, 0.f, 0.f, 0.f};
#pragma unroll
                    for (int ks = 0; ks < 4; ++ks) if (ks < nks) {
                        const bf16x8 X = *(const LAS bf16x8*)(Vt + (64 * h + 16 * db + fr) * VT_A + 32 * ks + 8 * fq);
                        acc = __builtin_amdgcn_mfma_f32_16x16x32_bf16(X, Y[ks], acc, 0, 0, 0);
                    }
                    float u0, u1, u2, u3; unpack2(ur[q][db].x, u0, u1); unpack2(ur[q][db].y, u2, u3);
                    const float a0 = u0 * (acc[0] + bias[q]), a1 = u1 * (acc[1] + bias[q]), a2 = u2 * (acc[2] + bias[q]), a3 = u3 * (acc[3] + bias[q]);
                    ssq += (a0 * a0 + a1 * a1) + (a2 * a2 + a3 * a3);
                    v2u o; o.x = cvt_pk_bf16(a0, a1); o.y = cvt_pk_bf16(a2, a3);
                    *(v2u*)(F.MIX + (m0 + t) * D + 64 * h + 16 * db + 4 * fq) = o;
                }
                ssq += __shfl_xor(ssq, 16); ssq += __shfl_xor(ssq, 32);
                if (fq == 0) part[t * 8 + h] = ssq;
            }
        }
    }
    __syncthreads();
    finalize_rows<16>(F, m0, 0, A.in[19]);
}

__device__ __forceinline__ void k_norm_rope(Frame& F, const bf16* zk, int prow, LAS bf16* krow, float* kout) {
    const __attribute__((address_space(4))) Args& A = *F.a; const float* gk = A.in[17];
    float ss = 0.f;
#pragma unroll
    for (int i = 0; i < 8; ++i) { float x[8]; unpack8(*(const v4u*)(zk + 8 * i), x);
#pragma unroll
        for (int j = 0; j < 8; ++j) ss += x[j] * x[j]; }
    const float rs = __builtin_amdgcn_rsqf(ss * (1.0f / 64.0f) + 1e-6f);
    const f32x2* tab = F.rope + prow * 32;
#pragma unroll 1
    for (int i = 0; i < 4; ++i) {
        float x1[8], x2[8], o1[8], o2[8]; unpack8(*(const v4u*)(zk + 8 * i), x1); unpack8(*(const v4u*)(zk + 32 + 8 * i), x2);
#pragma unroll
        for (int j = 0; j < 8; ++j) { const float a = x1[j] * rs * gk[8 * i + j], b = x2[j] * rs * gk[32 + 8 * i + j]; const f32x2 cs = tab[8 * i + j]; o1[j] = a * cs.x - b * cs.y; o2[j] = b * cs.x + a * cs.y; }
        *(LAS v4u*)(krow + 8 * i) = pack8(o1); *(LAS v4u*)(krow + 32 + 8 * i) = pack8(o2);
        if (kout) {
            *(f32x4*)(kout + 8 * i) = (f32x4){o1[0], o1[1], o1[2], o1[3]}; *(f32x4*)(kout + 8 * i + 4) = (f32x4){o1[4], o1[5], o1[6], o1[7]};
            *(f32x4*)(kout + 32 + 8 * i) = (f32x4){o2[0], o2[1], o2[2], o2[3]}; *(f32x4*)(kout + 32 + 8 * i + 4) = (f32x4){o2[4], o2[5], o2[6], o2[7]};
        }
        asm volatile("" ::: "memory");
    }
}
__device__ __forceinline__ void v_fill(const bf16* zv, LAS bf16* vcol  , float* vout) {
#pragma unroll 1
    for (int i = 0; i < 8; ++i) {
        const v4u raw = *(const v4u*)(zv + 8 * i); float x[8]; unpack8(raw, x);
#pragma unroll
        for (int j = 0; j < 8; ++j) vcol[(8 * i + j) * VP] = (bf16)(__float_as_uint(x[j]) >> 16);
        if (vout) { *(f32x4*)(vout + 8 * i) = (f32x4){x[0], x[1], x[2], x[3]}; *(f32x4*)(vout + 8 * i + 4) = (f32x4){x[4], x[5], x[6], x[7]}; }
        asm volatile("" ::: "memory");
    }
}

__device__ __forceinline__ void kv_fill(Frame& F, const bf16* zk, const bf16* zv, int prow, LAS bf16* krow, LAS bf16* vcol, float* kout, float* vout) {
    const Args __attribute__((address_space(4)))& A = *F.a; const float* gk = A.in[17];
    v4u rk[8], rv[8];
#pragma unroll
    for (int i = 0; i < 8; ++i) { rk[i] = *(const v4u*)(zk + 8 * i); rv[i] = *(const v4u*)(zv + 8 * i); }
    float ss = 0.f;
#pragma unroll
    for (int i = 0; i < 8; ++i) { float x[8]; unpack8(rk[i], x);
#pragma unroll
        for (int j = 0; j < 8; ++j) ss += x[j] * x[j]; }
    const float rs = __builtin_amdgcn_rsqf(ss * (1.0f / 64.0f) + 1e-6f);
    const f32x4* tab = (const f32x4*)(F.rope + prow * 32);
#pragma unroll
    for (int i = 0; i < 4; ++i) {
        float x1[8], x2[8], o1[8], o2[8]; unpack8(rk[i], x1); unpack8(rk[4 + i], x2);
        const f32x4 t0 = tab[4 * i], t1 = tab[4 * i + 1], t2 = tab[4 * i + 2], t3 = tab[4 * i + 3];
        const float cs[16] = {t0[0], t0[1], t0[2], t0[3], t1[0], t1[1], t1[2], t1[3], t2[0], t2[1], t2[2], t2[3], t3[0], t3[1], t3[2], t3[3]};
        const f32x4 ga = *(const f32x4*)(gk + 8 * i), gb = *(const f32x4*)(gk + 8 * i + 4), gc = *(const f32x4*)(gk + 32 + 8 * i), gd = *(const f32x4*)(gk + 32 + 8 * i + 4);
        const float g1[8] = {ga[0], ga[1], ga[2], ga[3], gb[0], gb[1], gb[2], gb[3]}, g2[8] = {gc[0], gc[1], gc[2], gc[3], gd[0], gd[1], gd[2], gd[3]};
#pragma unroll
        for (int j = 0; j < 8; ++j) { const float a = x1[j] * rs * g1[j], b = x2[j] * rs * g2[j]; o1[j] = a * cs[2 * j] - b * cs[2 * j + 1]; o2[j] = b * cs[2 * j] + a * cs[2 * j + 1]; }
        *(LAS v4u*)(krow + 8 * i) = pack8(o1); *(LAS v4u*)(krow + 32 + 8 * i) = pack8(o2);
        if (kout) {
            *(f32x4*)(kout + 8 * i) = (f32x4){o1[0], o1[1], o1[2], o1[3]}; *(f32x4*)(kout + 8 * i + 4) = (f32x4){o1[4], o1[5], o1[6], o1[7]};
            *(f32x4*)(kout + 32 + 8 * i) = (f32x4){o2[0], o2[1], o2[2], o2[3]}; *(f32x4*)(kout + 32 + 8 * i + 4) = (f32x4){o2[4], o2[5], o2[6], o2[7]};
        }
        asm volatile("" ::: "memory");
    }
#pragma unroll
    for (int i = 0; i < 8; ++i) {
        const unsigned wv[4] = {rv[i].x, rv[i].y, rv[i].z, rv[i].w};
#pragma unroll
        for (int q = 0; q < 4; ++q) { vcol[(8 * i + 2 * q) * VP] = (bf16)(wv[q] & 0xffffu); vcol[(8 * i + 2 * q + 1) * VP] = (bf16)(wv[q] >> 16); }
        if (vout) { float x[8]; unpack8(rv[i], x); *(f32x4*)(vout + 8 * i) = (f32x4){x[0], x[1], x[2], x[3]}; *(f32x4*)(vout + 8 * i + 4) = (f32x4){x[4], x[5], x[6], x[7]}; }
    }
}

struct QRaw { v4u q0, q1; f32x4 t[4]; };
__device__ __forceinline__ QRaw q_load(Frame& F, size_t mrow, int hq, int prow) {
    const int fq = F.lane >> 4; QRaw r;
    const bf16* zq = F.Z + mrow * NIN + 1024 + 64 * hq + 8 * fq;
    r.q0 = *(const v4u*)zq; r.q1 = *(const v4u*)(zq + 32);
    const f32x4* tab = (const f32x4*)(F.rope + prow * 32 + 8 * fq);
#pragma unroll
    for (int i = 0; i < 4; ++i) r.t[i] = tab[i];
    return r;
}
__device__ __forceinline__ void attn_qblock(Frame& F, const QRaw& qr, const float (&gq1)[8], const float (&gq2)[8], const LAS bf16* Kl, const LAS bf16* Vl, LAS float* partp, size_t mrow, int tq, int tq_lo, int tq_hi, int hq, float sink_nat, int kb0, int jmin) {
    const int fq = F.lane >> 4;
    float x1[8], x2[8]; unpack8(qr.q0, x1); unpack8(qr.q1, x2);
    float ss = 0.f;
#pragma unroll
    for (int j = 0; j < 8; ++j) ss += x1[j] * x1[j] + x2[j] * x2[j];
    ss += __shfl_xor(ss, 16); ss += __shfl_xor(ss, 32);
    const float rs = (0.125f * 1.4426950408889634f) * __builtin_amdgcn_rsqf(ss * (1.0f / 64.0f) + 1e-6f);
#pragma unroll
    for (int j = 0; j < 8; ++j) { const float a = x1[j] * rs * gq1[j], b = x2[j] * rs * gq2[j]; const float cc = qr.t[j >> 1][2 * (j & 1)], sn = qr.t[j >> 1][2 * (j & 1) + 1]; x1[j] = a * cc - b * sn; x2[j] = b * cc + a * sn; }
    const bf16x8 Yq0 = as_bf16x8(pack8(x1)), Yq1 = as_bf16x8(pack8(x2));
    f32x4 S[10];
#pragma unroll
    for (int kk = 0; kk < 10; ++kk) {
        const LAS bf16* kp = Kl + (16 * (kb0 + kk) + (F.lane & 15)) * KP + 8 * fq;
        const bf16x8 X0 = *(const LAS bf16x8*)kp, X1 = *(const LAS bf16x8*)(kp + 32);
        f32x4 a = {0.f, 0.f, 0.f, 0.f};
        a = __builtin_amdgcn_mfma_f32_16x16x32_bf16(X0, Yq0, a, 0, 0, 0);
        a = __builtin_amdgcn_mfma_f32_16x16x32_bf16(X1, Yq1, a, 0, 0, 0);
        S[kk] = a;
    }
    const float sink = sink_nat * 1.4426950408889634f;
    float mx = sink;
#pragma unroll
    for (int kk = 0; kk < 10; ++kk) {
        const int jb = 16 * (kb0 + kk);
        if (jb > tq_hi && jb + 15 <= tq_lo + 128 && jb >= jmin) {
#pragma unroll
            for (int v = 0; v < 4; ++v) mx = fmaxf(mx, S[kk][v]);
        } else {
#pragma unroll
            for (int v = 0; v < 4; ++v) { const int j = jb + 4 * fq + v; const bool ok = (j > tq) && (j <= tq + 128) && (j >= jmin); S[kk][v] = ok ? S[kk][v] : -INFINITY; mx = fmaxf(mx, S[kk][v]); }
        }
    }
    mx = fmaxf(mx, __shfl_xor(mx, 16)); mx = fmaxf(mx, __shfl_xor(mx, 32));
    float sum = 0.f;
#pragma unroll
    for (int kk = 0; kk < 10; ++kk)
#pragma unroll
        for (int v = 0; v < 4; ++v) { const float p = __builtin_amdgcn_exp2f(S[kk][v] - mx); S[kk][v] = p; sum += p; }
    sum += __shfl_xor(sum, 16); sum += __shfl_xor(sum, 32);
    const float inv = __builtin_amdgcn_rcpf(sum + __builtin_amdgcn_exp2f(sink - mx));
    bf16x8 Yp[5];
#pragma unroll
    for (int i = 0; i < 5; ++i) { v4u w; w.x = cvt_pk_bf16(S[2 * i][0], S[2 * i][1]); w.y = cvt_pk_bf16(S[2 * i][2], S[2 * i][3]); w.z = cvt_pk_bf16(S[2 * i + 1][0], S[2 * i + 1][1]); w.w = cvt_pk_bf16(S[2 * i + 1][2], S[2 * i + 1][3]); Yp[i] = as_bf16x8(w); }
    float ssq = 0.f;
#pragma unroll
    for (int db = 0; db < 4; ++db) {
        f32x4 o = {0.f, 0.f, 0.f, 0.f};
#pragma unroll
        for (int i = 0; i < 5; ++i) {
            const LAS bf16* vp = Vl + (16 * db + (F.lane & 15)) * VP + 16 * (kb0 + 2 * i) + 4 * fq;
            const v2u lo = *(const LAS v2u*)vp, hi = *(const LAS v2u*)(vp + 16);
            v4u xw; xw.x = lo.x; xw.y = lo.y; xw.z = hi.x; xw.w = hi.y;
            o = __builtin_amdgcn_mfma_f32_16x16x32_bf16(as_bf16x8(xw), Yp[i], o, 0, 0, 0);
        }
        o = o * inv; ssq += (o[0] * o[0] + o[1] * o[1]) + (o[2] * o[2] + o[3] * o[3]);
        v2u ow; ow.x = cvt_pk_bf16(o[0], o[1]); ow.y = cvt_pk_bf16(o[2], o[3]);
        *(v2u*)(F.MIX + mrow * D + 512 + 64 * hq + 16 * db + 4 * fq) = ow;
    }
    ssq += __shfl_xor(ssq, 16); ssq += __shfl_xor(ssq, 32);
    if (fq == 0) *partp = ssq;
}

__device__ __forceinline__ void mix_prompt_B(Frame& F, int n, int c) {
    const __attribute__((address_space(4))) Args& A = *F.a;
    LAS bf16* Kl = (LAS bf16*)F.lds; LAS bf16* Vl = (LAS bf16*)(F.lds + 2 * 256 * KP * 2); LAS float* part = (LAS float*)(F.lds + OFF_PART);
    const size_t m0 = (size_t)n * SEQ + (size_t)c * 128; const int lane = F.lane, w = F.wave, tid = F.tid;
    {
        const int kv = tid >> 8, j = tid & 255;
        LAS bf16* krow = Kl + (kv * 256 + j) * KP; LAS bf16* vcol = Vl + kv * 64 * VP + j;
        if (c == 0 && j < 128) {
#pragma unroll
            for (int i = 0; i < 8; ++i) *(LAS v4u*)(krow + 8 * i) = (v4u){0u, 0u, 0u, 0u};
            for (int d = 0; d < 64; ++d) vcol[d * VP] = 0;
        } else {
            const size_t mk = m0 - 128 + j; const bool tail = (c == 15 && j >= 128);
            float* kout = tail ? F.out + OUT_PKW + (((size_t)n * 128 + (j - 128)) * 2 + kv) * 64 : nullptr;
            float* vout = tail ? F.out + OUT_PVW + (((size_t)n * 128 + (j - 128)) * 2 + kv) * 64 : nullptr;
            kv_fill(F, F.Z + mk * NIN + 1536 + 64 * kv, F.Z + mk * NIN + 1664 + 64 * kv, (c - 1) * 128 + j, krow, vcol, kout, vout);
        }
    }
    __syncthreads();
    {
        const int h = w, kv = h >> 2, fr = lane & 15, fq = lane >> 4;
        float gq1[8], gq2[8];
#pragma unroll
        for (int j = 0; j < 8; ++j) { gq1[j] = A.in[16][8 * fq + j]; gq2[j] = A.in[16][32 + 8 * fq + j]; }
        const float sink = A.in[18][h];
        QRaw cur = q_load(F, m0 + fr, h, c * 128 + fr);
#pragma unroll 1
        for (int qb = 0; qb < 8; ++qb) {
            const int tq = 16 * qb + fr, tn = (qb < 7) ? tq + 16 : tq;
            const QRaw nxt = q_load(F, m0 + tn, h, c * 128 + tn);
            attn_qblock(F, cur, gq1, gq2, Kl + kv * 256 * KP, Vl + kv * 64 * VP, part + tq * 8 + h, m0 + tq, tq, 16 * qb, 16 * qb + 15, h, sink, qb & ~1, c == 0 ? 128 : 0);
            cur = nxt;
        }
    }
    __syncthreads();
    finalize_rows<16>(F, m0, 512, A.in[20]);
}

__device__ __forceinline__ void mix_sample_A(Frame& F, int n) {
    const __attribute__((address_space(4))) Args& A = *F.a;
    LAS float* red = (LAS float*)(F.lds + OFF_RED);
    const size_t m0 = (size_t)MP + (size_t)n * 8; const int lane = F.lane, w = F.wave, tid = F.tid;
    {
        const int col = tid, h = col >> 6;
        float v[8];
#pragma unroll
        for (int s = 0; s < 8; ++s) v[s] = bf2f(F.Z[(m0 + s) * NIN + 512 + col]);
        float my_mean, my_rstd;
        {
            const f32x4* p = (const f32x4*)((const float*)(A.ws + WS_VS) + (m0 + (lane & 7)) * 16);
            const f32x4 a4 = p[0], b4 = p[1], c4 = p[2], d4 = p[3];
            const float S1 = ((a4[0] + a4[2]) + (b4[0] + b4[2])) + ((c4[0] + c4[2]) + (d4[0] + d4[2])), S2 = ((a4[1] + a4[3]) + (b4[1] + b4[3])) + ((c4[1] + c4[3]) + (d4[1] + d4[3]));
            my_mean = S1 * (1.0f / 512.0f); my_rstd = __builtin_amdgcn_rsqf(fmaxf(S2 * (1.0f / 512.0f) - my_mean * my_mean, 0.f) + 1e-6f);
        }
        const float gc = A.in[12][col], bc = A.in[13][col];
#pragma unroll
        for (int s = 0; s < 8; ++s) {
            const float mean = __shfl(my_mean, s), rstd = __shfl(my_rstd, s);
            v[s] = (v[s] - mean) * rstd * gc + bc;
            F.out[OUT_SCV + ((size_t)n * 8 + s) * 512 + col] = v[s];
        }
        float a[8];
#pragma unroll
        for (int t = 0; t < 8; ++t) {
            const float* wr = A.in[14] + ((size_t)(h * 128 + t)) * 128; float mixed = A.in[15][h * 128 + t];
#pragma unroll
            for (int s = 0; s < 8; ++s) if (s <= t) mixed += wr[s] * v[s];
            a[t] = bf2f(F.Z[(m0 + t) * NIN + col]) * mixed;
            const float q = wave_sum(a[t] * a[t]); if (lane == 0) red[w * 16 + t] = q;
        }
        __syncthreads();
        const float go = A.in[19][col];
#pragma unroll
        for (int t = 0; t < 8; ++t) {
            float q = 0.f;
#pragma unroll
            for (int ww = 0; ww < 8; ++ww) q += red[ww * 16 + t];
            const float rs = __builtin_amdgcn_rsqf(q * (1.0f / 512.0f) + 1e-6f);
            F.MIX[(m0 + t) * D + col] = (bf16)(cvt_pk_bf16(a[t] * rs * go, 0.f) & 0xffffu);
        }
    }
}

__device__ __forceinline__ void mix_sample_B(Frame& F, int n) {
    const __attribute__((address_space(4))) Args& A = *F.a;
    LAS bf16* Kl = (LAS bf16*)F.lds; LAS bf16* Vl = (LAS bf16*)(F.lds + 2 * 256 * KP * 2); LAS float* part = (LAS float*)(F.lds + OFF_PART);
    const size_t m0 = (size_t)MP + (size_t)n * 8; const int lane = F.lane, w = F.wave, tid = F.tid;
    const int fr_q = lane & 15, fq_q = lane >> 4, hq_q = 2 * (w & 3) + (fr_q >> 3), t_q = fr_q & 7;
    const QRaw qr_pre = q_load(F, m0 + t_q, hq_q, 2048 + t_q);
    float gq1[8], gq2[8];
#pragma unroll
    for (int j = 0; j < 8; ++j) { gq1[j] = A.in[16][8 * fq_q + j]; gq2[j] = A.in[16][32 + 8 * fq_q + j]; }
    const float sink_q = A.in[18][hq_q];
    {
        const int kv = tid >> 8, j = (tid & 255) >> 1, hf = tid & 1;
        LAS bf16* krow = Kl + (kv * 256 + j) * KP + 32 * hf; LAS bf16* vcol = Vl + kv * 64 * VP + (32 * hf) * VP + j;
        const float* ck = A.in[4] + (((size_t)n * 128 + j) * 2 + kv) * 64 + 32 * hf; const float* cvp = A.in[5] + (((size_t)n * 128 + j) * 2 + kv) * 64 + 32 * hf;
        float* ko = F.out + OUT_SKW + (((size_t)n * 128 + (j - 8)) * 2 + kv) * 64 + 32 * hf; float* vo = F.out + OUT_SVW + (((size_t)n * 128 + (j - 8)) * 2 + kv) * 64 + 32 * hf;
        f32x4 kr[8], vr[8];
#pragma unroll
        for (int i = 0; i < 8; ++i) { kr[i] = *(const f32x4*)(ck + 4 * i); vr[i] = *(const f32x4*)(cvp + 4 * i); }
#pragma unroll
        for (int i = 0; i < 4; ++i) {
            const f32x4 k0 = kr[2 * i], k1 = kr[2 * i + 1], v0 = vr[2 * i], v1 = vr[2 * i + 1];
            v4u kw; kw.x = cvt_pk_bf16(k0[0], k0[1]); kw.y = cvt_pk_bf16(k0[2], k0[3]); kw.z = cvt_pk_bf16(k1[0], k1[1]); kw.w = cvt_pk_bf16(k1[2], k1[3]);
            *(LAS v4u*)(krow + 8 * i) = kw;
            const unsigned va = cvt_pk_bf16(v0[0], v0[1]), vb = cvt_pk_bf16(v0[2], v0[3]), vc = cvt_pk_bf16(v1[0], v1[1]), vd = cvt_pk_bf16(v1[2], v1[3]);
            vcol[(8 * i + 0) * VP] = (bf16)(va & 0xffffu); vcol[(8 * i + 1) * VP] = (bf16)(va >> 16); vcol[(8 * i + 2) * VP] = (bf16)(vb & 0xffffu); vcol[(8 * i + 3) * VP] = (bf16)(vb >> 16);
            vcol[(8 * i + 4) * VP] = (bf16)(vc & 0xffffu); vcol[(8 * i + 5) * VP] = (bf16)(vc >> 16); vcol[(8 * i + 6) * VP] = (bf16)(vd & 0xffffu); vcol[(8 * i + 7) * VP] = (bf16)(vd >> 16);
            if (j >= 8) { *(f32x4*)(ko + 8 * i) = k0; *(f32x4*)(ko + 8 * i + 4) = k1; *(f32x4*)(vo + 8 * i) = v0; *(f32x4*)(vo + 8 * i + 4) = v1; }
        }
        if (tid < 48) {
            const int kz = tid / 24, jz = 136 + tid % 24;
            LAS bf16* kz_row = Kl + (kz * 256 + jz) * KP; LAS bf16* vz = Vl + kz * 64 * VP + jz;
#pragma unroll
            for (int i = 0; i < 8; ++i) *(LAS v4u*)(kz_row + 8 * i) = (v4u){0u, 0u, 0u, 0u};
            for (int d = 0; d < 64; ++d) vz[d * VP] = 0;
        }
    }
    if (w == 7) {
        const int task = lane >> 2, q = lane & 3, t = task & 7, kv2 = task >> 3; const size_t mk = m0 + t;
        const bf16* zk = F.Z + mk * NIN + 1536 + 64 * kv2 + 8 * q; const bf16* zv = F.Z + mk * NIN + 1664 + 64 * kv2 + 8 * q;
        const v4u k0 = *(const v4u*)zk, k1 = *(const v4u*)(zk + 32), v0 = *(const v4u*)zv, v1 = *(const v4u*)(zv + 32);
        const f32x4* tab = (const f32x4*)(F.rope + (2048 + t) * 32 + 8 * q); f32x4 tt[4];
#pragma unroll
        for (int i = 0; i < 4; ++i) tt[i] = tab[i];
        const float* gk = A.in[17]; float g1[8], g2[8];
#pragma unroll
        for (int j2 = 0; j2 < 8; ++j2) { g1[j2] = gk[8 * q + j2]; g2[j2] = gk[32 + 8 * q + j2]; }
        float x1[8], x2[8], o1[8], o2[8]; unpack8(k0, x1); unpack8(k1, x2);
        float ss = 0.f;
#pragma unroll
        for (int j2 = 0; j2 < 8; ++j2) ss += x1[j2] * x1[j2] + x2[j2] * x2[j2];
        ss += __shfl_xor(ss, 1); ss += __shfl_xor(ss, 2);
        const float rs = __builtin_amdgcn_rsqf(ss * (1.0f / 64.0f) + 1e-6f);
#pragma unroll
        for (int j2 = 0; j2 < 8; ++j2) { const float a = x1[j2] * rs * g1[j2], b = x2[j2] * rs * g2[j2]; const float cc = tt[j2 >> 1][2 * (j2 & 1)], sn = tt[j2 >> 1][2 * (j2 & 1) + 1]; o1[j2] = a * cc - b * sn; o2[j2] = b * cc + a * sn; }
        LAS bf16* krow = Kl + (kv2 * 256 + 128 + t) * KP;
        *(LAS v4u*)(krow + 8 * q) = pack8(o1); *(LAS v4u*)(krow + 32 + 8 * q) = pack8(o2);
        float* ko = F.out + OUT_SKW + (((size_t)n * 128 + (120 + t)) * 2 + kv2) * 64; float* vo = F.out + OUT_SVW + (((size_t)n * 128 + (120 + t)) * 2 + kv2) * 64;
        *(f32x4*)(ko + 8 * q) = (f32x4){o1[0], o1[1], o1[2], o1[3]}; *(f32x4*)(ko + 8 * q + 4) = (f32x4){o1[4], o1[5], o1[6], o1[7]};
        *(f32x4*)(ko + 32 + 8 * q) = (f32x4){o2[0], o2[1], o2[2], o2[3]}; *(f32x4*)(ko + 32 + 8 * q + 4) = (f32x4){o2[4], o2[5], o2[6], o2[7]};
        LAS bf16* vcol = Vl + kv2 * 64 * VP + 128 + t;
        float y1[8], y2[8]; unpack8(v0, y1); unpack8(v1, y2);
#pragma unroll
        for (int e = 0; e < 8; ++e) { vcol[(8 * q + e) * VP] = (bf16)(__float_as_uint(y1[e]) >> 16); vcol[(32 + 8 * q + e) * VP] = (bf16)(__float_as_uint(y2[e]) >> 16); }
        *(f32x4*)(vo + 8 * q) = (f32x4){y1[0], y1[1], y1[2], y1[3]}; *(f32x4*)(vo + 8 * q + 4) = (f32x4){y1[4], y1[5], y1[6], y1[7]};
        *(f32x4*)(vo + 32 + 8 * q) = (f32x4){y2[0], y2[1], y2[2], y2[3]}; *(f32x4*)(vo + 32 + 8 * q + 4) = (f32x4){y2[4], y2[5], y2[6], y2[7]};
    }
    __syncthreads();
    if (w < 4) {
        const int hq = hq_q, t = t_q, kv = w >> 1;
        attn_qblock(F, qr_pre, gq1, gq2, Kl + kv * 256 * KP, Vl + kv * 64 * VP, part + t * 8 + hq, m0 + t, t, 0, 7, hq, sink_q, 0, 0);
    }
    __syncthreads();
    finalize_rows<1>(F, m0, 512, A.in[20]);
}

__device__ __forceinline__ void p4_mixer(Frame& F) {
    const int b = blockIdx.x, G = F.G;
#ifndef NO_A
    for (int it = b; it < 128; it += G) { __syncthreads(); mix_prompt_A(F, it >> 4, it & 15); }
#endif
    asm volatile("" ::: "memory");
#ifndef NO_B
    for (int it = b + ((128 - b + G * 64) / G) * 0; it < 256; it += G) { if (it >= 128) { __syncthreads(); mix_prompt_B(F, (it - 128) >> 4, (it - 128) & 15); } }
#endif
    asm volatile("" ::: "memory");
#ifndef NO_S
    for (int it = b; it < 128; it += G) { __syncthreads(); mix_sample_B(F, it); }
    asm volatile("" ::: "memory");
    for (int it = b; it < 256; it += G) { if (it >= 128) { __syncthreads(); mix_sample_A(F, it - 128); } }
#endif
}

#define XB_TMO      128
#define XB_XCNT(j)  (256  + 64 * (j))
#define XB_XSUB(j)  (1280 + 64 * (j))
#define XB_XGEN(j)  (2304 + 64 * (j))
#define XB_TOP      3328
#define XB_TOPGEN   3392
#define XCD_BAR_WORDS 3456
#define XB_SPIN_CAP (1u << 18)

__device__ __forceinline__ unsigned xb_ld(unsigned* p)              { return __hip_atomic_load(p, __ATOMIC_RELAXED, __HIP_MEMORY_SCOPE_AGENT); }
__device__ __forceinline__ unsigned xb_add(unsigned* p, unsigned v) { return __hip_atomic_fetch_add(p, v, __ATOMIC_RELAXED, __HIP_MEMORY_SCOPE_AGENT); }
__device__ __forceinline__ unsigned xb_xcc_id() { return (unsigned)__builtin_amdgcn_s_getreg((3 << 11) | 20) & 0xFu; }
#define XB_SPIN(cond, bar) do { unsigned _sp = 0; while (cond) { __builtin_amdgcn_s_sleep(1); \
    if ((++_sp & 255u) == 0u) { if (xb_ld(&(bar)[XB_TMO])) break; if (_sp > XB_SPIN_CAP) { atomicAdd(&(bar)[XB_TMO], 1u); break; } } } } while (0)

struct XcdBarrier {
    unsigned* bar; unsigned x;
    volatile LAS unsigned* st;
};

__device__ __forceinline__ XcdBarrier xcd_barrier_post(unsigned* bar, volatile LAS unsigned* st) {
    XcdBarrier b; b.bar = bar; b.x = xb_xcc_id(); b.st = st;
    if (threadIdx.x == 0) (void)xb_add(&bar[XB_XCNT(b.x)], 1u);
    return b;
}
__device__ __forceinline__ void xcd_barrier_complete(unsigned* bar, unsigned x, unsigned& nloc, unsigned& nx) {
    const unsigned G = gridDim.x * gridDim.y * gridDim.z;
    unsigned sum, cnt, mine, sp = 0u;
    for (;;) {
        sum = 0u; cnt = 0u; mine = 0u;
#pragma unroll
        for (unsigned j = 0; j < 16; ++j) { const unsigned c = xb_ld(&bar[XB_XCNT(j)]); sum += c; cnt += (c > 0u) ? 1u : 0u; mine = (j == x) ? c : mine; }
        if (sum == G) break;
        __builtin_amdgcn_s_sleep(1);
        if ((++sp & 255u) == 0u) { if (xb_ld(&bar[XB_TMO])) break; if (sp > XB_SPIN_CAP) { atomicAdd(&bar[XB_TMO], 1u); break; } }
    }
    nloc = mine > 0u ? mine : 1u; nx = cnt > 0u ? cnt : 1u;
}

__device__ __forceinline__ void xcd_barrier(const XcdBarrier& b) {
    asm volatile("s_waitcnt vmcnt(0)" ::: "memory");
    __syncthreads();
    if (threadIdx.x == 0) {
        unsigned* bar = b.bar;
        __builtin_amdgcn_s_waitcnt(0);
        unsigned nloc = b.st[0], nx = b.st[1];
        if (nloc == 0u) { xcd_barrier_complete(bar, b.x, nloc, nx); b.st[0] = nloc; b.st[1] = nx; }
        const unsigned old = xb_add(&bar[XB_XSUB(b.x)], 1u);
        const unsigned gen = old / nloc;
        if (old + 1u == (gen + 1u) * nloc) {
            __builtin_amdgcn_fence(__ATOMIC_RELEASE, "agent");
            asm volatile("s_waitcnt vmcnt(0)" ::: "memory");
            const unsigned og = xb_add(&bar[XB_TOP], 1u);
            const unsigned tg = og / nx;
            if (og + 1u == (tg + 1u) * nx) xb_add(&bar[XB_TOPGEN], 1u);
            else XB_SPIN(xb_ld(&bar[XB_TOPGEN]) == tg, bar);
            __builtin_amdgcn_fence(__ATOMIC_ACQUIRE, "agent");
            asm volatile("s_waitcnt vmcnt(0)" ::: "memory");
        } else {
            XB_SPIN(xb_ld(&bar[XB_TOPGEN]) == gen, bar);
            __builtin_amdgcn_fence(__ATOMIC_ACQUIRE, "agent");
            asm volatile("s_waitcnt vmcnt(0)" ::: "memory");
        }
    }
    __syncthreads();
}

template <class Elem>
__device__ __forceinline__ void gemm_small64(LAS unsigned char* lds, const bf16* A, const bf16* Bt, int K, int r0, int c0, const Elem& E) {
    int tid_ = threadIdx.x; asm volatile("" : "+v"(tid_));
    const int tid = tid_, lane = tid & 63, w = __builtin_amdgcn_readfirstlane(tid >> 6), fr = lane & 15, fq = lane >> 4;
    const int kw = K >> 3, k0 = w * kw;
    f32x4 acc[4][4];
#pragma unroll
    for (int i = 0; i < 4; ++i)
#pragma unroll
        for (int j = 0; j < 4; ++j) acc[i][j] = (f32x4){0.f, 0.f, 0.f, 0.f};
    const bf16* ap = A + (size_t)(r0 + fr) * K + k0 + 8 * fq;
    const bf16* bp = Bt + (size_t)(c0 + fr) * K + k0 + 8 * fq;
    const size_t s16 = (size_t)16 * K;
#pragma unroll 4
    for (int ks = 0; ks < kw; ks += 32) {
        bf16x8 a[4], b[4];
#pragma unroll
        for (int i = 0; i < 4; ++i) { a[i] = *(const bf16x8*)(ap + i * s16 + ks); b[i] = *(const bf16x8*)(bp + i * s16 + ks); }
#pragma unroll
        for (int rb = 0; rb < 4; ++rb)
#pragma unroll
            for (int cb = 0; cb < 4; ++cb) acc[rb][cb] = __builtin_amdgcn_mfma_f32_16x16x32_bf16(b[cb], a[rb], acc[rb][cb], 0, 0, 0);
    }
    LAS float* P = (LAS float*)lds;
#pragma unroll
    for (int rb = 0; rb < 4; ++rb)
#pragma unroll
        for (int cb = 0; cb < 4; ++cb) *(LAS f32x4*)(P + (w * 64 + rb * 16 + fr) * 68 + cb * 16 + 4 * fq) = acc[rb][cb];
    __syncthreads();
    const int row = tid >> 3, c8 = (tid & 7) * 8;
    f32x4 v0 = {0.f, 0.f, 0.f, 0.f}, v1 = {0.f, 0.f, 0.f, 0.f};
#pragma unroll
    for (int ww = 0; ww < 8; ++ww) { v0 += *(const LAS f32x4*)(P + (ww * 64 + row) * 68 + c8); v1 += *(const LAS f32x4*)(P + (ww * 64 + row) * 68 + c8 + 4); }
    float ss = E.elem8(r0 + row, c0 + c8, v0, v1);
    if (Elem::HAS_SS) { ss += __shfl_xor(ss, 1); ss += __shfl_xor(ss, 2); ss += __shfl_xor(ss, 4); if ((tid & 7) == 0) E.row_ss(r0 + row, c0 >> 6, ss); }
    __syncthreads();
}
struct ElemRes {
    static constexpr bool HAS_SS = true;
    bf16* XB; float* SS; float alpha;
    __device__ __forceinline__ float elem8(int r, int c, f32x4 a0, f32x4 a1) const {
        bf16* xp = XB + (size_t)r * D + c; float x[8]; unpack8(*(const v4u*)xp, x);
#pragma unroll
        for (int j = 0; j < 4; ++j) { x[j] += a0[j] * alpha; x[4 + j] += a1[j] * alpha; }
        *(v4u*)xp = pack8(x);
        float ss = 0.f;
#pragma unroll
        for (int j = 0; j < 8; ++j) ss += x[j] * x[j];
        return ss;
    }
    __device__ __forceinline__ void row_ss(int r, int slot, float ss) const { SS[(size_t)r * 16 + slot] = ss; }
};
struct ElemPle {
    static constexpr bool HAS_SS = false;
    const bf16* XB; const bf16* P; float* Y; const float* SS;
    __device__ __forceinline__ float elem8(int r, int c, f32x4 a0, f32x4 a1) const {
        const float rs = pg8::row_rs(SS, r); const size_t off = (size_t)r * D + c;
        float x[8], p[8]; unpack8(*(const v4u*)(XB + off), x); unpack8(*(const v4u*)(P + off), p); f32x4 o0, o1;
#pragma unroll
        for (int j = 0; j < 4; ++j) { o0[j] = x[j] + __builtin_amdgcn_rcpf(1.0f + __expf(-a0[j] * rs)) * p[j]; o1[j] = x[4 + j] + __builtin_amdgcn_rcpf(1.0f + __expf(-a1[j] * rs)) * p[4 + j]; }
        *(f32x4*)(Y + off) = o0; *(f32x4*)(Y + off + 4) = o1; return 0.f;
    }
    __device__ __forceinline__ void row_ss(int, int, float) const {}
};
struct ElemBf {
    static constexpr bool HAS_SS = false;
    bf16* P;
    __device__ __forceinline__ float elem8(int r, int c, f32x4 a0, f32x4 a1) const { float x[8] = {a0[0], a0[1], a0[2], a0[3], a1[0], a1[1], a1[2], a1[3]}; *(v4u*)(P + (size_t)r * D + c) = pack8(x); return 0.f; }
    __device__ __forceinline__ void row_ss(int, int, float) const {}
};
template <class Elem>
__device__ __forceinline__ void gemm_sample_rows(Frame& F, const bf16* A, const bf16* Bt, int K, const Elem& E) {
    for (int st = blockIdx.x; st < 256; st += F.G) gemm_small64<Elem>(F.lds, A, Bt, K, MP + 64 * (st >> 4), 64 * (st & 15), E);
}

__global__ void __launch_bounds__(NWAVES * 64, 2) fwd_megakernel(Args args) {
    extern __shared__ __attribute__((aligned(16))) unsigned char lds_raw[];
    cg::grid_group grid = cg::this_grid();
    Frame F;
    F.lds = (LAS unsigned char*)lds_raw; F.tid = threadIdx.x; F.lane = F.tid & 63; F.wave = __builtin_amdgcn_readfirstlane(F.tid >> 6); F.G = gridDim.x;
    const __attribute__((address_space(4))) Args* KA = (const __attribute__((address_space(4))) Args*)__builtin_amdgcn_kernarg_segment_ptr();
    F.a = KA; F.out = KA->out;
    unsigned char* ws = KA->ws;
    F.Z = (bf16*)(ws + WS_Z); F.MIX = (bf16*)(ws + WS_MIX); F.rope = (const f32x2*)(ws + WS_ROPE);
    bf16* XG = (bf16*)(ws + WS_XB); bf16* ACT = (bf16*)(ws + WS_ACT); bf16* PRJ = (bf16*)(ws + WS_PRJ); float* SS = (float*)(ws + WS_SS);
    const int lo = KA->ph_lo, hi = KA->ph_hi;
    const bool spread = (F.G == 256);
#ifndef PH_MASK
#define PH_MASK 0x1ff
#endif
#define IN(k) (((PH_MASK >> (k)) & 1) && lo <= (k) && (k) < hi)
    if (F.tid < 64) ((LAS unsigned*)(F.lds + OFF_MISC))[F.tid] = 0u;
    __syncthreads();
    const XcdBarrier bar = xcd_barrier_post((unsigned*)(ws + WS_CTL), (volatile LAS unsigned*)(F.lds + OFF_MISC));
    if (lo > 1000) grid.sync();
#define SEAM(k) do { if (IN(k) && IN((k) + 1)) xcd_barrier(bar); } while (0)
    if (IN(0)) { p0_prologue(F); } SEAM(0);
    if (IN(1)) {
        pg8::Gemm g{XG, (const bf16*)(ws + WS_W1T), MT, 2 * FF, D}; pg8::StaticOrder S; S.init(MT, 2 * FF, F.G, (int)blockIdx.x);
        pg8::EpiAct E{ACT, SS, FF};
        pg8::gemm_phase<pg8::EpiAct, pg8::StaticOrder, true, true>(F.lds, g, S, E);
        if (spread) {
            const int k = (int)blockIdx.x - 216; pg8::RangeOrder R{k >= 0 ? 2 * k : 0, k >= 0 ? 2 * k + 2 : 0};
            pg8::Gemm gp{(const bf16*)(ws + WS_PE), (const bf16*)(ws + WS_WPP), MP, D, DPLE}; pg8::EpiBf Ep{PRJ};
            pg8::gemm_phase<pg8::EpiBf, pg8::RangeOrder, true, true>(F.lds, gp, R, Ep);
        }
    } SEAM(1);
    if (IN(2)) {
        pg8::Gemm g{ACT, (const bf16*)(ws + WS_W1D), MP, D, FF}; pg8::StaticOrder S; S.init(MP, D, F.G, (int)blockIdx.x);
        pg8::EpiRes E{XG, SS, 0.5f};
        pg8::gemm_phase<pg8::EpiRes, pg8::StaticOrder, true, true>(F.lds, g, S, E);
        ElemRes Es{XG, SS, 0.5f};
        gemm_sample_rows<ElemRes>(F, ACT, (const bf16*)(ws + WS_W1D), FF, Es);
    } SEAM(2);
    if (IN(3)) {
        { pg8::Gemm g{XG, (const bf16*)(ws + WS_WIN), MT, NIN, D}; pg8::StaticOrder S; S.init(MT, NIN, F.G, (int)blockIdx.x);
          pg8::EpiZ E{F.Z, SS, NIN, 4, (float*)(ws + WS_VS)};
          pg8::gemm_phase<pg8::EpiZ, pg8::StaticOrder, true, true>(F.lds, g, S, E); }
        if (spread) {
            const int k = (int)blockIdx.x - 220; const int f = k < 0 ? 0 : (k < 24 ? 160 + 3 * k : 232 + 2 * (k - 24)), n = k < 0 ? 0 : (k < 24 ? 3 : 2); pg8::RangeOrder R{f, f + n};
            pg8::Gemm gp{(const bf16*)(ws + WS_PE), (const bf16*)(ws + WS_WPP), MP, D, DPLE}; pg8::EpiBf Ep{PRJ};
            pg8::gemm_phase<pg8::EpiBf, pg8::RangeOrder, true, true>(F.lds, gp, R, Ep);
        }
    } SEAM(3);
    if (IN(4)) { p4_mixer(F); } SEAM(4);
    if (IN(5)) {
        pg8::Gemm g{F.MIX, (const bf16*)(ws + WS_WO), MP, D, D}; pg8::StaticOrder S; S.init(MP, D, F.G, (int)blockIdx.x);
        pg8::EpiRes E{XG, SS, 1.0f};
        pg8::gemm_phase<pg8::EpiRes, pg8::StaticOrder, true, true>(F.lds, g, S, E);
        ElemRes Es{XG, SS, 1.0f};
        gemm_sample_rows<ElemRes>(F, F.MIX, (const bf16*)(ws + WS_WO), D, Es);
    } SEAM(5);
    if (IN(6)) {
        pg8::Gemm g{XG, (const bf16*)(ws + WS_W2T), MT, 2 * FF, D}; pg8::StaticOrder S; S.init(MT, 2 * FF, F.G, (int)blockIdx.x);
        pg8::EpiAct E{ACT, SS, FF};
        pg8::gemm_phase<pg8::EpiAct, pg8::StaticOrder, true, true>(F.lds, g, S, E);
        if (spread) {
            const int k = (int)blockIdx.x - 216; pg8::RangeOrder R{k >= 0 ? 80 + 2 * k : 0, k >= 0 ? 80 + 2 * k + 2 : 0};
            pg8::Gemm gp{(const bf16*)(ws + WS_PE), (const bf16*)(ws + WS_WPP), MP, D, DPLE}; pg8::EpiBf Ep{PRJ};
            pg8::gemm_phase<pg8::EpiBf, pg8::RangeOrder, true, true>(F.lds, gp, R, Ep);
        }
    } SEAM(6);
    if (IN(7)) {
        pg8::Gemm g{ACT, (const bf16*)(ws + WS_W2D), MP, D, FF}; pg8::StaticOrder S; S.init(MP, D, F.G, (int)blockIdx.x);
        pg8::EpiRes E{XG, SS, 0.5f};
        pg8::gemm_phase<pg8::EpiRes, pg8::StaticOrder, true, true>(F.lds, g, S, E);
        ElemRes Es{XG, SS, 0.5f};
        gemm_sample_rows<ElemRes>(F, ACT, (const bf16*)(ws + WS_W2D), FF, Es);
    } SEAM(7);
    if (IN(8)) {
        pg8::Gemm g{(const bf16*)(ws + WS_PE), (const bf16*)(ws + WS_WPP), MP, D, DPLE}; pg8::StaticOrder S; S.init(MP, D, F.G, (int)blockIdx.x);
        pg8::EpiBf E{PRJ};
        if (!spread) pg8::gemm_phase<pg8::EpiBf, pg8::StaticOrder, true, true>(F.lds, g, S, E);
        ElemBf Es{PRJ};
        gemm_sample_rows<ElemBf>(F, (const bf16*)(ws + WS_PE), (const bf16*)(ws + WS_WPP), DPLE, Es);
        asm volatile("s_waitcnt vmcnt(0)" ::: "memory"); __syncthreads();
    }
    if (IN(8)) {
        pg8::Gemm g{XG, (const bf16*)(ws + WS_WPG), MP, D, D}; pg8::StaticOrder S; S.init(MP, D, F.G, (int)blockIdx.x);
        pg8::EpiPle E{XG, PRJ, F.out + OUT_Y, SS};
        pg8::gemm_phase<pg8::EpiPle, pg8::StaticOrder, true, true>(F.lds, g, S, E);
        ElemPle Es{XG, PRJ, F.out + OUT_Y, SS};
        gemm_sample_rows<ElemPle>(F, XG, (const bf16*)(ws + WS_WPG), D, Es);
    }
#undef IN
#undef SEAM
}

#ifndef MK_N_LAUNCHES
#define MK_N_LAUNCHES 1
#endif
extern "C" void kernel_launch(void* const* d_in, const int* in_sizes, int n_in, void* d_out, int out_size, void* d_ws, size_t ws_size, hipStream_t stream) {
    static int grid = 0;
    if (grid == 0) {
        if (n_in != 29 || out_size != (int)OUT_END || ws_size < WS_TOP) { fprintf(stderr, "kernel_launch: unexpected shapes (n_in %d out %d ws %zu)\n", n_in, out_size, ws_size); grid = -1; return; }
        int dev = 0, cus = 0, per_cu = 0;
        hipGetDevice(&dev); hipDeviceGetAttribute(&cus, hipDeviceAttributeMultiprocessorCount, dev);
        if (hipFuncSetAttribute((const void*)fwd_megakernel, hipFuncAttributeMaxDynamicSharedMemorySize, LDS_BYTES) != hipSuccess) { fprintf(stderr, "kernel_launch: hipFuncSetAttribute failed\n"); grid = -1; return; }
        if (hipOccupancyMaxActiveBlocksPerMultiprocessor(&per_cu, (const void*)fwd_megakernel, NWAVES * 64, LDS_BYTES) != hipSuccess || per_cu < 1) { fprintf(stderr, "kernel_launch: occupancy query says %d\n", per_cu); per_cu = 1; }
        (void)hipGetLastError();
        grid = cus * per_cu;
        fprintf(stderr, "kernel_launch: grid %d (cus %d x %d)\n", grid, cus, per_cu);
    }
    if (grid < 0) return;
    Args a{};
    for (int i = 0; i < 29; ++i) a.in[i] = (const float*)d_in[i];
    a.out = (float*)d_out; a.ws = (unsigned char*)d_ws;
    if (hipMemsetAsync((char*)d_ws + WS_CTL, 0, CTL_BYTES, stream) != hipSuccess) { fprintf(stderr, "kernel_launch: memset failed\n"); return; }
    if (MK_N_LAUNCHES == 1) {
        a.ph_lo = 0; a.ph_hi = 9;
        void* kargs[] = {&a};
        const hipError_t e = hipLaunchCooperativeKernel((const void*)fwd_megakernel, dim3(grid), dim3(NWAVES * 64), kargs, LDS_BYTES, stream);
        if (e != hipSuccess) fprintf(stderr, "kernel_launch: cooperative launch failed: %s (grid %d)\n", hipGetErrorString(e), grid);
    } else {
        for (int p = 0; p < 9; ++p) { a.ph_lo = p; a.ph_hi = p + 1; hipLaunchKernelGGL(fwd_megakernel, dim3(grid), dim3(NWAVES * 64), LDS_BYTES, stream, a); }
    }
}
```

```cpp
#include <hip/hip_runtime.h>
#include <hip/hip_cooperative_groups.h>
#include <cstdio>
#include <cstdint>
#include <cmath>
namespace cg = cooperative_groups;
namespace pg8 {
#define PG8_LAS __attribute__((address_space(3)))
typedef unsigned short bf16_t;
typedef short bf16x8 __attribute__((ext_vector_type(8)));
typedef float f32x4 __attribute__((ext_vector_type(4)));
typedef unsigned u32x4 __attribute__((ext_vector_type(4)));
constexpr int BM = 256, BK = 64, HALF = 128, HTB = HALF * BK * 2  , STAGE_BYTES = 8 * HTB, NXCD = 8, WGM = 8;

__host__ __device__ __forceinline__ int lds_byte(int r, int c) { const int st = (r >> 4) * 2 + (c >> 5), rr = r & 15, cc = c & 31, ob = rr * 64 + cc * 2; return st * 1024 + (ob ^ (((ob >> 9) & 1) << 5)); }
__host__ __device__ __forceinline__ void stage_rc(int b, int& R, int& C) { const int st = b / 1024, sb = b % 1024, swz = sb ^ (((sb >> 9) & 1) << 5); R = (st >> 1) * 16 + swz / 64; C = (st & 1) * 32 + (swz % 64) / 2; }
__host__ __device__ __forceinline__ int perm32(int rho) { const int n = rho >> 4, i = rho & 15; return 8 * (i >> 2) + 4 * n + (i & 3); }

struct Unit { int pm, pn; };
struct Gemm { const bf16_t* A; const bf16_t* Bt; int M, N, K; };

struct StaticOrder {
    int nM, nN, nwg, G, c;
    __host__ __device__ void init(int M, int N, int G_, int c_) { nM = M / BM; nN = N / BM; nwg = nM * nN; G = G_; c = c_; }
    __host__ __device__ bool next(int i, Unit& u) const {
        const long L = (long)i * G + c; if (L >= nwg) return false;
        int wgid = (int)L; { const int q = nwg / NXCD, r = nwg % NXCD, xcd = wgid % NXCD, off = wgid / NXCD; wgid = (xcd < r ? xcd * (q + 1) : r * (q + 1) + (xcd - r) * q) + off; }
        const int nig = WGM * nN, gid = wgid / nig, fm = gid * WGM, gsz = (nM - fm) < WGM ? (nM - fm) : WGM;
        u.pm = fm + ((wgid % nig) % gsz); u.pn = (wgid % nig) / gsz; return true;
    }
    __device__ __forceinline__ void a_ready(const Unit&) const {}
    __device__ __forceinline__ void done(const Unit&) const {}
};

struct RangeOrder {
    int first, last;
    __host__ __device__ bool next(int i, Unit& u) const { const int idx = first + i; if (idx >= last) return false; u.pm = idx >> 2; u.pn = idx & 3; return true; }
    __device__ __forceinline__ void a_ready(const Unit&) const {}
    __device__ __forceinline__ void done(const Unit&) const {}
};

__device__ __forceinline__ unsigned cvt_pk_bf16(float lo, float hi) { unsigned r; asm volatile("v_cvt_pk_bf16_f32 %0, %1, %2" : "=v"(r) : "v"(lo), "v"(hi)); return r; }
typedef float f32x2 __attribute__((ext_vector_type(2)));
__device__ __forceinline__ float fast_rcp(float x) { return __builtin_amdgcn_rcpf(x); }
__device__ __forceinline__ float row_rs(const float* SS, int r) {
    const f32x4* p = (const f32x4*)(SS + (size_t)r * 16);
    const f32x4 a = p[0], b = p[1], c = p[2], d = p[3];
    const f32x4 s = (a + b) + (c + d);
    const float t = (s[0] + s[1]) + (s[2] + s[3]);
    return __builtin_amdgcn_rsqf(t * (1.0f / 1024.0f) + 1e-6f);
}
__device__ __forceinline__ void row_rs8(const float* SS, int row0, int fq, float (&rsv)[2][4]) {
    f32x4 q[2][4];
#pragma unroll
    for (int ai = 0; ai < 2; ++ai)
#pragma unroll
        for (int m = 0; m < 4; ++m) q[ai][m] = *(const f32x4*)(SS + (size_t)(row0 + ai * HALF + m * 16) * 16 + 4 * fq);
#pragma unroll
    for (int ai = 0; ai < 2; ++ai)
#pragma unroll
        for (int m = 0; m < 4; ++m) { float t = (q[ai][m][0] + q[ai][m][1]) + (q[ai][m][2] + q[ai][m][3]); t += __shfl_xor(t, 16); t += __shfl_xor(t, 32); rsv[ai][m] = __builtin_amdgcn_rsqf(t * (1.0f / 1024.0f) + 1e-6f); }
}
struct EpiAct {
    static constexpr bool PERM = true, AFTER_DRAIN = false;
    bf16_t* O; const float* SS; int ldo;
    __device__ __forceinline__ void operator()(const f32x4 (&acc)[2][2][4][2], const Unit& u, int wr, int wc, int fr, int fq) const {
        const int row0 = u.pm * BM + wr * 64 + fr, col0 = u.pn * HALF + wc * 32 + 8 * fq;
        float rsv[2][4]; row_rs8(SS, row0, fq, rsv);
#pragma unroll
        for (int ai = 0; ai < 2; ++ai)
#pragma unroll
            for (int m = 0; m < 4; ++m) {
                const int r = row0 + ai * HALF + m * 16; const float rs = rsv[ai][m], nrs = rs * -1.4426950408889634f, rs2 = rs * rs;
                float o[8];
#pragma unroll
                for (int n = 0; n < 2; ++n) {
                    const f32x4 t = acc[ai][0][m][n] * nrs, p = (acc[ai][0][m][n] * acc[ai][1][m][n]) * rs2;
#pragma unroll
                    for (int j = 0; j < 4; ++j) o[4 * n + j] = p[j] * fast_rcp(1.0f + __builtin_amdgcn_exp2f(t[j]));
                }
                u32x4 w; w.x = cvt_pk_bf16(o[0], o[1]); w.y = cvt_pk_bf16(o[2], o[3]); w.z = cvt_pk_bf16(o[4], o[5]); w.w = cvt_pk_bf16(o[6], o[7]);
                *(u32x4*)(O + (size_t)r * ldo + col0) = w;
            }
    }
};
struct EpiRes {
    static constexpr bool PERM = true, AFTER_DRAIN = false;
    bf16_t* XB; float* SS; float alpha;
    __device__ __forceinline__ void operator()(const f32x4 (&acc)[2][2][4][2], const Unit& u, int wr, int wc, int fr, int fq) const {
        const int row0 = u.pm * BM + wr * 64 + fr, col0 = u.pn * BM + wc * 32 + 8 * fq;
        u32x4 rb[2][4][2];
#pragma unroll
        for (int ai = 0; ai < 2; ++ai)
#pragma unroll
            for (int m = 0; m < 4; ++m) { const bf16_t* xq = XB + (size_t)(row0 + ai * HALF + m * 16) * 1024 + col0; rb[ai][m][0] = *(const u32x4*)xq; rb[ai][m][1] = *(const u32x4*)(xq + HALF); }
#pragma unroll
        for (int ai = 0; ai < 2; ++ai) {
#pragma unroll
            for (int m = 0; m < 4; ++m) {
                const int r = row0 + ai * HALF + m * 16;
                bf16_t* xp = XB + (size_t)r * 1024 + col0;
                const u32x4 b0 = rb[ai][m][0], b1 = rb[ai][m][1];
                float ss = 0.f;
#pragma unroll
                for (int bj = 0; bj < 2; ++bj) {
                    const u32x4 b = bj ? b1 : b0;
                    f32x4 v0, v1;
                    v0[0] = __uint_as_float(b.x << 16); v0[1] = __uint_as_float(b.x & 0xffff0000u); v0[2] = __uint_as_float(b.y << 16); v0[3] = __uint_as_float(b.y & 0xffff0000u);
                    v1[0] = __uint_as_float(b.z << 16); v1[1] = __uint_as_float(b.z & 0xffff0000u); v1[2] = __uint_as_float(b.w << 16); v1[3] = __uint_as_float(b.w & 0xffff0000u);
                    v0 += acc[ai][bj][m][0] * alpha; v1 += acc[ai][bj][m][1] * alpha;
                    ss += (v0[0] * v0[0] + v0[1] * v0[1]) + (v0[2] * v0[2] + v0[3] * v0[3]) + (v1[0] * v1[0] + v1[1] * v1[1]) + (v1[2] * v1[2] + v1[3] * v1[3]);
                    u32x4 w; w.x = cvt_pk_bf16(v0[0], v0[1]); w.y = cvt_pk_bf16(v0[2], v0[3]); w.z = cvt_pk_bf16(v1[0], v1[1]); w.w = cvt_pk_bf16(v1[2], v1[3]);
                    *(u32x4*)(xp + bj * HALF) = w;
                }
                ss += __shfl_xor(ss, 16); ss += __shfl_xor(ss, 32);
                if (fq == 0) SS[(size_t)r * 16 + u.pn * 4 + wc] = ss;
            }
        }
    }
};
struct EpiZ {
    static constexpr bool PERM = true, AFTER_DRAIN = false;
    bf16_t* O; const float* SS; int ldo, gelu_tiles; float* VS;
    __device__ __forceinline__ void operator()(const f32x4 (&acc)[2][2][4][2], const Unit& u, int wr, int wc, int fr, int fq) const {
        const int row0 = u.pm * BM + wr * 64 + fr, col0 = u.pn * BM + wc * 32 + 8 * fq;
        float rsv[2][4]; row_rs8(SS, row0, fq, rsv);
        const bool va_tile = (u.pn == 2 || u.pn == 3);
#pragma unroll
        for (int ai = 0; ai < 2; ++ai)
#pragma unroll
            for (int m = 0; m < 4; ++m) {
                const int r = row0 + ai * HALF + m * 16; const float rs = rsv[ai][m];
                float s1 = 0.f, s2 = 0.f;
#pragma unroll
                for (int bj = 0; bj < 2; ++bj) {
                    f32x4 a = acc[ai][bj][m][0] * rs, b = acc[ai][bj][m][1] * rs;
                    if (u.pn < gelu_tiles) {
#pragma unroll
                        for (int j = 0; j < 4; ++j) { const float ua = 1.5957691216057308f * a[j] * (1.0f + 0.044715f * a[j] * a[j]), ub = 1.5957691216057308f * b[j] * (1.0f + 0.044715f * b[j] * b[j]);
                            a[j] = a[j] * fast_rcp(1.0f + __expf(-ua)); b[j] = b[j] * fast_rcp(1.0f + __expf(-ub)); }
                    }
                    if (va_tile) {
                        s1 += ((a[0] + a[1]) + (a[2] + a[3])) + ((b[0] + b[1]) + (b[2] + b[3]));
                        s2 += ((a[0] * a[0] + a[1] * a[1]) + (a[2] * a[2] + a[3] * a[3])) + ((b[0] * b[0] + b[1] * b[1]) + (b[2] * b[2] + b[3] * b[3]));
                    }
                    u32x4 w; w.x = cvt_pk_bf16(a[0], a[1]); w.y = cvt_pk_bf16(a[2], a[3]); w.z = cvt_pk_bf16(b[0], b[1]); w.w = cvt_pk_bf16(b[2], b[3]);
                    *(u32x4*)(O + (size_t)r * ldo + col0 + bj * HALF) = w;
                }
                if (va_tile) {
                    s1 += __shfl_xor(s1, 16); s1 += __shfl_xor(s1, 32); s2 += __shfl_xor(s2, 16); s2 += __shfl_xor(s2, 32);
                    if (fq == 0) *(f32x2*)(VS + (size_t)r * 16 + ((u.pn - 2) * 4 + wc) * 2) = (f32x2){s1, s2};
                }
            }
    }
};
struct EpiBf {
    static constexpr bool PERM = true, AFTER_DRAIN = false;
    bf16_t* P;
    __device__ __forceinline__ void operator()(const f32x4 (&acc)[2][2][4][2], const Unit& u, int wr, int wc, int fr, int fq) const {
        const int row0 = u.pm * BM + wr * 64 + fr, col0 = u.pn * BM + wc * 32 + 8 * fq;
#pragma unroll
        for (int ai = 0; ai < 2; ++ai)
#pragma unroll
            for (int m = 0; m < 4; ++m) {
                const int r = row0 + ai * HALF + m * 16;
#pragma unroll
                for (int bj = 0; bj < 2; ++bj) { const f32x4 a = acc[ai][bj][m][0], b = acc[ai][bj][m][1];
                    u32x4 w; w.x = cvt_pk_bf16(a[0], a[1]); w.y = cvt_pk_bf16(a[2], a[3]); w.z = cvt_pk_bf16(b[0], b[1]); w.w = cvt_pk_bf16(b[2], b[3]);
                    *(u32x4*)(P + (size_t)r * 1024 + col0 + bj * HALF) = w; }
            }
    }
};
struct EpiPle {
    static constexpr bool PERM = true, AFTER_DRAIN = false;
    const bf16_t* XB; const bf16_t* P; float* Y; const float* SS;
    __device__ __forceinline__ void operator()(const f32x4 (&acc)[2][2][4][2], const Unit& u, int wr, int wc, int fr, int fq) const {
        const int row0 = u.pm * BM + wr * 64 + fr, col0 = u.pn * BM + wc * 32 + 8 * fq;
        float rsv[2][4]; row_rs8(SS, row0, fq, rsv);
#pragma unroll
        for (int ai = 0; ai < 2; ++ai)
#pragma unroll
            for (int mp = 0; mp < 2; ++mp) {
                u32x4 xr[2][2], pr[2][2];
#pragma unroll
                for (int mm = 0; mm < 2; ++mm)
#pragma unroll
                    for (int bj = 0; bj < 2; ++bj) { const size_t off = (size_t)(row0 + ai * HALF + (2 * mp + mm) * 16) * 1024 + col0 + bj * HALF; xr[mm][bj] = *(const u32x4*)(XB + off); pr[mm][bj] = *(const u32x4*)(P + off); }
#pragma unroll
                for (int mm = 0; mm < 2; ++mm) {
                    const int m = 2 * mp + mm; const int r = row0 + ai * HALF + m * 16; const float nrs = rsv[ai][m] * -1.4426950408889634f;
#pragma unroll
                    for (int bj = 0; bj < 2; ++bj) {
                        const size_t off = (size_t)r * 1024 + col0 + bj * HALF;
                        const unsigned xw[4] = {xr[mm][bj].x, xr[mm][bj].y, xr[mm][bj].z, xr[mm][bj].w}, pw[4] = {pr[mm][bj].x, pr[mm][bj].y, pr[mm][bj].z, pr[mm][bj].w};
                        f32x4 o[2];
#pragma unroll
                        for (int q = 0; q < 4; ++q) {
                            const float t0 = acc[ai][bj][m][q >> 1][2 * (q & 1)] * nrs, t1 = acc[ai][bj][m][q >> 1][2 * (q & 1) + 1] * nrs;
                            o[q >> 1][2 * (q & 1)] = __uint_as_float(xw[q] << 16) + fast_rcp(1.0f + __builtin_amdgcn_exp2f(t0)) * __uint_as_float(pw[q] << 16);
                            o[q >> 1][2 * (q & 1) + 1] = __uint_as_float(xw[q] & 0xffff0000u) + fast_rcp(1.0f + __builtin_amdgcn_exp2f(t1)) * __uint_as_float(pw[q] & 0xffff0000u);
                        }
                        *(f32x4*)(Y + off) = o[0]; *(f32x4*)(Y + off + 4) = o[1];
                    }
                }
            }
    }
};

template <class Epi, class Sched, bool ALIGN_EPI = false, bool SP2 = false>
__device__ __forceinline__ void gemm_phase(PG8_LAS unsigned char* lds, const Gemm g, const Sched& S, const Epi& E) {
    int tid_ = threadIdx.x; asm volatile("" : "+v"(tid_));
    const int tid = tid_, wid = __builtin_amdgcn_readfirstlane(tid >> 6), lane = tid & 63, wr = wid >> 2, wc = wid & 3, fr = lane & 15, fq = lane >> 4;
    int K_ = g.K; asm volatile("" : "+s"(K_));
    const int K = K_, nt = K / BK;
    unsigned voffA[2], voffB[2];
#pragma unroll
    for (int i = 0; i < 2; ++i) { int R, C; stage_rc(tid * 16 + i * 8192, R, C); const int Rb = Epi::PERM ? ((R & ~31) + perm32(R & 31)) : R;
        voffA[i] = (unsigned)(R * K + C) * 2u; voffB[i] = (unsigned)(Rb * K + C) * 2u; }
    const size_t kstep = (size_t)(BK * 2);
    const size_t hstep = (size_t)HALF * K * 2;
    const size_t tstep = 2 * hstep;
    const unsigned ldsw = (unsigned)wid * 1024u;
    const int aoff = lds_byte(wr * 64 + fr, fq * 8), boff = lds_byte(wc * 32 + fr, fq * 8);
#define PG8_SA(b, h) (((b) * 2 + (h)) * HTB)
#define PG8_SB(b, h) ((4 + (b) * 2 + (h)) * HTB)
#define PG8_STAGE(bufoff, gbase, voff) do { _Pragma("unroll") for (int _i = 0; _i < 2; ++_i) \
        __builtin_amdgcn_global_load_lds((const unsigned*)((const char*)(gbase) + (voff)[_i]), (PG8_LAS unsigned*)(lds + (bufoff) + ldsw + _i * 8192), 16, 0, 0); } while (0)
#define PG8_LDA(dst, b, h) do { _Pragma("unroll") for (int m = 0; m < 4; ++m) _Pragma("unroll") for (int k = 0; k < 2; ++k) dst[m][k] = *(const PG8_LAS bf16x8*)(lds + PG8_SA(b, h) + aoff + m * 2048 + k * 1024); } while (0)
#define PG8_LDB(dst, b, h) do { _Pragma("unroll") for (int n = 0; n < 2; ++n) _Pragma("unroll") for (int k = 0; k < 2; ++k) dst[n][k] = *(const PG8_LAS bf16x8*)(lds + PG8_SB(b, h) + boff + n * 2048 + k * 1024); } while (0)
#define PG8_MMA(ai, bj, At, Bt) do { __builtin_amdgcn_s_setprio(1); _Pragma("unroll") for (int m = 0; m < 4; ++m) _Pragma("unroll") for (int n = 0; n < 2; ++n) _Pragma("unroll") for (int k = 0; k < 2; ++k) \
        acc[ai][bj][m][n] = __builtin_amdgcn_mfma_f32_16x16x32_bf16(Bt[n][k], At[m][k], acc[ai][bj][m][n], 0, 0, 0); __builtin_amdgcn_s_setprio(0); } while (0)
#define PG8_WAIT_V(n) asm volatile("s_waitcnt vmcnt(" #n ")" ::: "memory")
#define PG8_WAIT_L(n) asm volatile("s_waitcnt lgkmcnt(" #n ")" ::: "memory")
#define PG8_BAR __builtin_amdgcn_s_barrier()
#define PG8_SCHED __builtin_amdgcn_sched_barrier(0)
    Unit cur, nxt; int ui = 0;
    if (!S.next(0, cur)) return;
    f32x4 acc[2][2][4][2];
#pragma unroll
    for (int a = 0; a < 2; ++a)
#pragma unroll
        for (int b = 0; b < 2; ++b)
#pragma unroll
            for (int m = 0; m < 4; ++m)
#pragma unroll
                for (int n = 0; n < 2; ++n) acc[a][b][m][n] = (f32x4){0.f, 0.f, 0.f, 0.f};
    bf16x8 At[4][2], B0[2][2], B1[2][2];
    const char* cA = (const char*)g.A + (size_t)cur.pm * tstep; const char* cB = (const char*)g.Bt + (size_t)cur.pn * tstep;
    S.a_ready(cur);
    if constexpr (SP2) {
        PG8_STAGE(PG8_SB(0, 0), cB, voffB); PG8_STAGE(PG8_SB(0, 1), cB + hstep, voffB); PG8_STAGE(PG8_SA(0, 0), cA, voffA); PG8_STAGE(PG8_SA(0, 1), cA + hstep, voffA);
        if (wr == 1) PG8_BAR;
        PG8_WAIT_V(2); PG8_BAR;
        PG8_STAGE(PG8_SB(1, 0), cB + kstep, voffB); PG8_STAGE(PG8_SA(1, 0), cA + kstep, voffA); PG8_STAGE(PG8_SB(1, 1), cB + hstep + kstep, voffB);
        PG8_WAIT_V(6); PG8_BAR;
    } else {
        PG8_STAGE(PG8_SB(0, 0), cB, voffB); PG8_STAGE(PG8_SA(0, 0), cA, voffA); PG8_STAGE(PG8_SB(0, 1), cB + hstep, voffB); PG8_STAGE(PG8_SA(0, 1), cA + hstep, voffA);
        if (wr == 1) PG8_BAR;
        PG8_WAIT_V(4); PG8_BAR;
        PG8_STAGE(PG8_SB(1, 0), cB + kstep, voffB); PG8_STAGE(PG8_SA(1, 0), cA + kstep, voffA); PG8_STAGE(PG8_SB(1, 1), cB + hstep + kstep, voffB);
        PG8_WAIT_V(6); PG8_BAR;
    }
    for (;;) {
        const bool has_next = S.next(ui + 1, nxt);
        const char* nA = has_next ? (const char*)g.A + (size_t)nxt.pm * tstep : cA; const char* nB = has_next ? (const char*)g.Bt + (size_t)nxt.pn * tstep : cB;
        asm volatile(".p2align 8");
        for (int t = 0; t < nt; t += 2) {
            const bool last = (t == nt - 2);
            const char* a1 = cA + (size_t)(t + 1) * kstep;
            const char* a2 = last ? nA : cA + (size_t)(t + 2) * kstep; const char* b2 = last ? nB : cB + (size_t)(t + 2) * kstep;
            const char* a3 = a2 + kstep; const char* b3 = b2 + kstep;
            if (last && has_next) S.a_ready(nxt);
            if constexpr (SP2) {
            PG8_LDB(B0, 0, 0); PG8_LDB(B1, 0, 1); PG8_SCHED; PG8_LDA(At, 0, 0); PG8_STAGE(PG8_SA(1, 1), a1 + hstep, voffA);
            PG8_WAIT_V(8); PG8_WAIT_L(0); PG8_BAR; PG8_MMA(0, 0, At, B0); PG8_MMA(0, 1, At, B1); PG8_BAR; PG8_SCHED;
            PG8_LDA(At, 0, 1); PG8_STAGE(PG8_SB(0, 0), b2, voffB); PG8_STAGE(PG8_SB(0, 1), b2 + hstep, voffB); PG8_STAGE(PG8_SA(0, 0), a2, voffA);
            PG8_WAIT_V(8); PG8_WAIT_L(0); PG8_BAR; PG8_MMA(1, 0, At, B0); PG8_MMA(1, 1, At, B1); PG8_BAR; PG8_SCHED;
            PG8_LDB(B0, 1, 0); PG8_LDB(B1, 1, 1); PG8_SCHED; PG8_LDA(At, 1, 0); PG8_STAGE(PG8_SA(0, 1), a2 + hstep, voffA);
            PG8_WAIT_V(8); PG8_WAIT_L(0); PG8_BAR; PG8_MMA(0, 0, At, B0); PG8_MMA(0, 1, At, B1); PG8_BAR; PG8_SCHED;
            PG8_LDA(At, 1, 1); PG8_STAGE(PG8_SB(1, 0), b3, voffB); PG8_STAGE(PG8_SB(1, 1), b3 + hstep, voffB); PG8_STAGE(PG8_SA(1, 0), a3, voffA);
            PG8_WAIT_V(8); PG8_WAIT_L(0); PG8_BAR; PG8_MMA(1, 0, At, B0); PG8_MMA(1, 1, At, B1); PG8_BAR; PG8_SCHED;
            } else {
            PG8_LDB(B0, 0, 0); PG8_SCHED; PG8_LDA(At, 0, 0); PG8_STAGE(PG8_SA(1, 1), a1 + hstep, voffA);
            PG8_WAIT_L(8); PG8_BAR; PG8_WAIT_L(0); PG8_MMA(0, 0, At, B0); PG8_BAR; PG8_SCHED;
            PG8_LDB(B1, 0, 1); PG8_STAGE(PG8_SB(0, 0), b2, voffB);
            PG8_BAR; PG8_WAIT_L(0); PG8_MMA(0, 1, At, B1); PG8_BAR;
            PG8_LDA(At, 0, 1); PG8_STAGE(PG8_SA(0, 0), a2, voffA);
            PG8_BAR; PG8_WAIT_L(0); PG8_MMA(1, 0, At, B0); PG8_BAR; PG8_SCHED;
            PG8_STAGE(PG8_SB(0, 1), b2 + hstep, voffB);
            PG8_WAIT_V(6); PG8_BAR; PG8_MMA(1, 1, At, B1); PG8_BAR;
            PG8_LDB(B0, 1, 0); PG8_SCHED; PG8_LDA(At, 1, 0); PG8_STAGE(PG8_SA(0, 1), a2 + hstep, voffA);
            PG8_WAIT_L(8); PG8_BAR; PG8_WAIT_L(0); PG8_MMA(0, 0, At, B0); PG8_BAR; PG8_SCHED;
            PG8_LDB(B1, 1, 1); PG8_STAGE(PG8_SB(1, 0), b3, voffB);
            PG8_BAR; PG8_WAIT_L(0); PG8_MMA(0, 1, At, B1); PG8_BAR;
            PG8_LDA(At, 1, 1); PG8_STAGE(PG8_SA(1, 0), a3, voffA);
            PG8_BAR; PG8_WAIT_L(0); PG8_MMA(1, 0, At, B0); PG8_BAR; PG8_SCHED;
            PG8_STAGE(PG8_SB(1, 1), b3 + hstep, voffB);
            PG8_WAIT_V(6); PG8_BAR; PG8_MMA(1, 1, At, B1); PG8_BAR;
            }
        }
        if constexpr (ALIGN_EPI) { if (wr == 0) PG8_BAR; }
        if constexpr (!Epi::AFTER_DRAIN) { E(acc, cur, wr, wc, fr, fq); S.done(cur); }
        if (!has_next) break;
#pragma unroll
        for (int a = 0; a < 2; ++a)
#pragma unroll
            for (int b = 0; b < 2; ++b)
#pragma unroll
                for (int m = 0; m < 4; ++m)
#pragma unroll
                    for (int n = 0; n < 2; ++n) acc[a][b][m][n] = (f32x4){0.f, 0.f, 0.f, 0.f};
        cur = nxt; cA = nA; cB = nB; ++ui;
        if constexpr (ALIGN_EPI) { if (wr == 1) PG8_BAR; }
    }
    PG8_WAIT_V(0);
    if constexpr (!ALIGN_EPI) { if (wr == 0) PG8_BAR; }
    PG8_BAR;
    if constexpr (Epi::AFTER_DRAIN) { E.fused(acc, cur, wr, wc, fr, fq, lds, wid, lane); S.done(cur); }
#undef PG8_SA
#undef PG8_SB
#undef PG8_STAGE
#undef PG8_LDA
#undef PG8_LDB
#undef PG8_MMA
#undef PG8_WAIT_V
#undef PG8_WAIT_L
#undef PG8_BAR
#undef PG8_SCHED
}
}
constexpr int NWAVES = 8;
constexpr int MP = 16384, MS = 1024, MT = MP + MS;
constexpr int D = 1024, FF = 2816, NIN = 1792, DPLE = 256, SEQ = 2048, PAST = 16384;
constexpr int ROPE_ROWS = 2048 + 8;
constexpr size_t OUT_Y = 0, OUT_PKW = 17825792, OUT_PVW = 17956864, OUT_PCV = 18087936, OUT_SKW = 18612224, OUT_SVW = 20709376, OUT_SCV = 22806528, OUT_END = 23330816;
constexpr size_t WS_W1T = 0, WS_W1D = WS_W1T + 11534336, WS_WIN = WS_W1D + 5767168, WS_WO = WS_WIN + 3670016, WS_W2T = WS_WO + 2097152, WS_W2D = WS_W2T + 11534336,
                 WS_WPG = WS_W2D + 5767168, WS_WPP = WS_WPG + 2097152, WS_R = WS_WPP + 524288;
constexpr size_t WS_ACT = WS_R, WS_Z = WS_R, WS_MIX = WS_R + (size_t)MT * NIN * 2;
constexpr size_t WS_PRJ = WS_R + (size_t)MT * FF * 2, WS_XB = WS_PRJ + (size_t)MT * D * 2, WS_SS = WS_XB + (size_t)MT * D * 2, WS_PE = WS_SS + (size_t)MT * 16 * 4,
                 WS_ROPE = WS_PE + (size_t)MT * DPLE * 2, WS_END = WS_ROPE + (size_t)ROPE_ROWS * 32 * 8;
constexpr int XCD_BAR_WORDS_C = 3456;
constexpr size_t WS_CTL = WS_END, CTL_BYTES = 16384, WS_VS = WS_CTL + CTL_BYTES, WS_WSB = WS_VS + (size_t)MT * 16 * 4, WS_TOP = WS_WSB + (size_t)8 * 128 * 128 * 2;
static_assert(WS_MIX + (size_t)MT * D * 2 <= WS_PRJ && WS_CTL % 256 == 0 && WS_TOP <= 268435456 && XCD_BAR_WORDS_C * 4 <= CTL_BYTES, "d_ws map");
constexpr int LDS_BYTES = 155648, OFF_MISC = LDS_BYTES - 256;

#define LAS __attribute__((address_space(3)))
typedef unsigned short bf16;
typedef unsigned v4u __attribute__((ext_vector_type(4)));
typedef unsigned v2u __attribute__((ext_vector_type(2)));
typedef float f32x4 __attribute__((ext_vector_type(4)));
typedef float f32x2 __attribute__((ext_vector_type(2)));
typedef short bf16x8 __attribute__((ext_vector_type(8)));
typedef __bf16 bf16x2_t __attribute__((ext_vector_type(2)));
__device__ __forceinline__ unsigned cvt_pk_bf16(float lo, float hi) { const f32x2 v = {lo, hi}; const bf16x2_t b = __builtin_convertvector(v, bf16x2_t); return __builtin_bit_cast(unsigned, b); }

struct Args {
    const float* in[29]; float* out; unsigned char* ws; int ph_lo, ph_hi;
};

struct Frame {
    LAS unsigned char* lds; int tid, lane, wave, G;
    const __attribute__((address_space(4))) Args* a; float* out;
    bf16 *Z, *MIX; const f32x2* rope;
};

__device__ __forceinline__ float wave_sum(float v) {
#pragma unroll
    for (int o = 1; o < 64; o <<= 1) v += __shfl_xor(v, o);
    return v;
}
__device__ __forceinline__ float bf2f(unsigned short h) { return __uint_as_float((unsigned)h << 16); }
__device__ __forceinline__ void unpack2(unsigned w, float& lo, float& hi) { lo = __uint_as_float(w << 16); hi = __uint_as_float(w & 0xffff0000u); }
__device__ __forceinline__ void unpack8(const v4u w, float* f) { unpack2(w.x, f[0], f[1]); unpack2(w.y, f[2], f[3]); unpack2(w.z, f[4], f[5]); unpack2(w.w, f[6], f[7]); }
__device__ __forceinline__ v4u pack8(const float* f) { v4u w; w.x = cvt_pk_bf16(f[0], f[1]); w.y = cvt_pk_bf16(f[2], f[3]); w.z = cvt_pk_bf16(f[4], f[5]); w.w = cvt_pk_bf16(f[6], f[7]); return w; }
__device__ __forceinline__ bf16x8 as_bf16x8(const v4u w) { return __builtin_bit_cast(bf16x8, w); }
__device__ __forceinline__ float gelu_tanh(float x) {
    const float u = 1.5957691216057308f * x * (1.0f + 0.044715f * x * x);
    return x * __builtin_amdgcn_rcpf(1.0f + __expf(-u));
}

struct TItem { const float* W; const float* gk; bf16* WT; int K, N, mode, item; };
struct TRegs { f32x4 v[8]; };
__device__ __forceinline__ TRegs t_load(const TItem& t, int lane) {
    const int nblk = t.N / 32, kb = t.item / nblk, nb = t.item % nblk, k0 = 64 * kb, n0 = 32 * nb; TRegs r;
    const float* p = t.W + (size_t)(k0 + (lane >> 3)) * t.N + n0 + 4 * (lane & 7);
#pragma unroll
    for (int i = 0; i < 8; ++i) r.v[i] = *(const f32x4*)(p + (size_t)(8 * i) * t.N);
    if (t.gk) {
#pragma unroll
        for (int i = 0; i < 8; ++i) r.v[i] = r.v[i] * t.gk[k0 + (lane >> 3) + 8 * i];
    }
    return r;
}
__device__ __forceinline__ void t_store(const TItem& t, const TRegs& r, LAS float* scr, int lane) {
    const int nblk = t.N / 32, kb = t.item / nblk, nb = t.item % nblk, k0 = 64 * kb, n0 = 32 * nb;
    const int rbase = (t.mode == 0) ? n0 : (((n0 >> 7) << 8) + (n0 & 127) + (t.mode == 2 ? 128 : 0));
#pragma unroll
    for (int i = 0; i < 8; ++i) { LAS float* d = scr + ((lane >> 3) + 8 * i) * 33 + 4 * (lane & 7); d[0] = r.v[i][0]; d[1] = r.v[i][1]; d[2] = r.v[i][2]; d[3] = r.v[i][3]; }
    asm volatile("s_waitcnt lgkmcnt(0)" ::: "memory");
    const int c = lane & 7;
#pragma unroll
    for (int j = 0; j < 4; ++j) { const int n = (lane >> 3) + 8 * j; const LAS float* s = scr + (8 * c) * 33 + n;
        v4u o; o.x = cvt_pk_bf16(s[0 * 33], s[1 * 33]); o.y = cvt_pk_bf16(s[2 * 33], s[3 * 33]); o.z = cvt_pk_bf16(s[4 * 33], s[5 * 33]); o.w = cvt_pk_bf16(s[6 * 33], s[7 * 33]);
        *(v4u*)(t.WT + (size_t)(rbase + n) * t.K + k0 + 8 * c) = o; }
    asm volatile("s_waitcnt lgkmcnt(0)" ::: "memory");
}
__device__ __forceinline__ TItem t_decode(Frame& F, int it) {
    const __attribute__((address_space(4))) Args& A = *F.a; unsigned char* ws = A.ws;
    constexpr int I_FU = (D / 64) * (FF / 32), I_IN = (D / 64) * (NIN / 32), I_SQ = (D / 64) * (D / 32);
    TItem t; int r = it;
    if (r < I_FU) { t = TItem{A.in[7], A.in[6], (bf16*)(ws + WS_W1T), D, FF, 1, r}; return t; } r -= I_FU;
    if (r < I_FU) { t = TItem{A.in[8], A.in[6], (bf16*)(ws + WS_W1T), D, FF, 2, r}; return t; } r -= I_FU;
    if (r < I_FU) { t = TItem{A.in[9], nullptr, (bf16*)(ws + WS_W1D), FF, D, 0, r}; return t; } r -= I_FU;
    if (r < I_FU) { t = TItem{A.in[23], A.in[22], (bf16*)(ws + WS_W2T), D, FF, 1, r}; return t; } r -= I_FU;
    if (r < I_FU) { t = TItem{A.in[24], A.in[22], (bf16*)(ws + WS_W2T), D, FF, 2, r}; return t; } r -= I_FU;
    if (r < I_FU) { t = TItem{A.in[25], nullptr, (bf16*)(ws + WS_W2D), FF, D, 0, r}; return t; } r -= I_FU;
    if (r < I_IN) { t = TItem{A.in[11], A.in[10], (bf16*)(ws + WS_WIN), D, NIN, 0, r}; return t; } r -= I_IN;
    if (r < I_SQ) { t = TItem{A.in[21], nullptr, (bf16*)(ws + WS_WO), D, D, 0, r}; return t; } r -= I_SQ;
    if (r < I_SQ) { t = TItem{A.in[27], A.in[26], (bf16*)(ws + WS_WPG), D, D, 0, r}; return t; } r -= I_SQ;
    t = TItem{A.in[28], nullptr, (bf16*)(ws + WS_WPP), DPLE, D, 0, r}; return t;
}
__device__ __forceinline__ void p0_prologue(Frame& F) {
    const __attribute__((address_space(4))) Args& A = *F.a; unsigned char* ws = A.ws;
    LAS float* scr = (LAS float*)(F.lds + F.wave * 16384);
    const int gw = blockIdx.x * NWAVES + F.wave, NGW = F.G * NWAVES;
    constexpr int I_FU = (D / 64) * (FF / 32), I_FD = (FF / 64) * (D / 32), I_IN = (D / 64) * (NIN / 32), I_SQ = (D / 64) * (D / 32), I_PP = (DPLE / 64) * (D / 32);
    constexpr int NITEMS = 6 * I_FU + I_IN + 2 * I_SQ + I_PP;
    static_assert(I_FU == I_FD, "");
    {
        TItem t0 = t_decode(F, gw < NITEMS ? gw : 0), t1 = t_decode(F, gw + NGW < NITEMS ? gw + NGW : 0);
        TRegs r0 = t_load(t0, F.lane), r1 = t_load(t1, F.lane);
#pragma unroll 1
        for (int it = gw; it < NITEMS; it += 2 * NGW) {
            const int n0 = it + 2 * NGW, n1 = it + 3 * NGW;
            const TItem u0 = t_decode(F, n0 < NITEMS ? n0 : 0), u1 = t_decode(F, n1 < NITEMS ? n1 : 0);
            const TRegs q0 = t_load(u0, F.lane), q1 = t_load(u1, F.lane);
            t_store(t0, r0, scr, F.lane);
            if (it + NGW < NITEMS) t_store(t1, r1, scr, F.lane);
            t0 = u0; t1 = u1; r0 = q0; r1 = q1;
        }
    }
    bf16* XB = (bf16*)(ws + WS_XB); float* SS = (float*)(ws + WS_SS); bf16* PE = (bf16*)(ws + WS_PE);
#pragma unroll 1
    for (int m0 = gw; m0 < MT; m0 += 2 * NGW) {
        f32x4 v[2][4], pv[2]; int mm[2];
#pragma unroll
        for (int q = 0; q < 2; ++q) {
            const int m = (m0 + q * NGW < MT) ? m0 + q * NGW : m0; mm[q] = m;
            const float* xrow = (m < MP) ? A.in[0] + (size_t)m * D : A.in[1] + (size_t)(m - MP) * D;
            const float* prow = (m < MP) ? A.in[2] + (size_t)m * DPLE : A.in[3] + (size_t)(m - MP) * DPLE;
#pragma unroll
            for (int j = 0; j < 4; ++j) v[q][j] = *((const f32x4*)xrow + F.lane + 64 * j);
            pv[q] = *((const f32x4*)prow + F.lane);
        }
#pragma unroll
        for (int q = 0; q < 2; ++q) {
            const int m = mm[q]; float s = 0.f;
#pragma unroll
            for (int j = 0; j < 4; ++j) s += (v[q][j][0] * v[q][j][0] + v[q][j][1] * v[q][j][1]) + (v[q][j][2] * v[q][j][2] + v[q][j][3] * v[q][j][3]);
            s = wave_sum(s);
            v2u* o8 = (v2u*)(XB + (size_t)m * D) + F.lane;
#pragma unroll
            for (int j = 0; j < 4; ++j) { v2u w; w.x = cvt_pk_bf16(v[q][j][0], v[q][j][1]); w.y = cvt_pk_bf16(v[q][j][2], v[q][j][3]); o8[64 * j] = w; }
            if (F.lane < 16) SS[(size_t)m * 16 + F.lane] = (F.lane == 0) ? s : 0.f;
            v2u w; w.x = cvt_pk_bf16(pv[q][0], pv[q][1]); w.y = cvt_pk_bf16(pv[q][2], pv[q][3]);
            *((v2u*)(PE + (size_t)m * DPLE) + F.lane) = w;
        }
    }
    {
        bf16* WSB = (bf16*)(ws + WS_WSB); const float* wsrc = A.in[14];
        for (int e = blockIdx.x * (NWAVES * 64) + F.tid; e < 8 * 128 * 128 / 2; e += F.G * NWAVES * 64) {
            const int t = (e >> 6) & 127, s0 = 2 * (e & 63); const f32x2 v = *(const f32x2*)(wsrc + 2 * e);
            *(unsigned*)(WSB + 2 * e) = cvt_pk_bf16(s0 <= t ? v[0] : 0.f, s0 + 1 <= t ? v[1] : 0.f);
        }
    }
    f32x2* rope = (f32x2*)(ws + WS_ROPE);
    for (int e = blockIdx.x * (NWAVES * 64) + F.tid; e < ROPE_ROWS * 32; e += F.G * NWAVES * 64) {
        const int pr = e >> 5, i = e & 31; const int pos = pr < 2048 ? pr : PAST + (pr - 2048);
        const double inv = (double)exp2f(-(float)i * (13.287712379549449f / 32.0f));
        double t = (double)pos * inv * 0.15915494309189535; t -= floor(t);
        const float f = (float)t;
        rope[e] = (f32x2){__builtin_amdgcn_cosf(f), __builtin_amdgcn_sinf(f)};
    }
}

constexpr int VT_A = 136;
constexpr int KP = 72, VP = 264;
constexpr int LDS_PART = 141312 + 4096 - 4096;
constexpr int OFF_PART = 141312, OFF_RED = OFF_PART + 4096, OFF_STAT = OFF_RED + 1024;
static_assert(512 * VT_A * 2 <= OFF_PART && 2 * 256 * KP * 2 + 2 * 64 * VP * 2 <= OFF_PART && OFF_STAT + 1024 <= OFF_MISC, "mixer LDS map");

template <int PW>
__device__ __forceinline__ void finalize_rows(Frame& F, size_t m0, int coloff, const float* g) {
    const LAS float* part = (const LAS float*)(F.lds + OFF_PART);
    float gv[8];
#pragma unroll
    for (int j = 0; j < 8; ++j) gv[j] = g[8 * F.lane + j];
    constexpr int BATCH = PW < 8 ? PW : 8;
#pragma unroll 1
    for (int i0 = 0; i0 < PW; i0 += BATCH) {
        v4u raw[BATCH];
#pragma unroll
        for (int i = 0; i < BATCH; ++i) raw[i] = *(const v4u*)(F.MIX + (m0 + F.wave * PW + i0 + i) * D + coloff + 8 * F.lane);
#pragma unroll
        for (int i = 0; i < BATCH; ++i) {
            const int tt = F.wave * PW + i0 + i;
            const f32x4 p0 = *(const LAS f32x4*)(part + tt * 8), p1 = *(const LAS f32x4*)(part + tt * 8 + 4);
            const float tot = ((p0[0] + p0[1]) + (p0[2] + p0[3])) + ((p1[0] + p1[1]) + (p1[2] + p1[3]));
            const float rs = __builtin_amdgcn_rsqf(tot * (1.0f / 512.0f) + 1e-6f);
            float x[8]; unpack8(raw[i], x);
#pragma unroll
            for (int j = 0; j < 8; ++j) x[j] = x[j] * rs * gv[j];
            *(v4u*)(F.MIX + (m0 + tt) * D + coloff + 8 * F.lane) = pack8(x);
        }
    }
}

__device__ __forceinline__ void mix_prompt_A(Frame& F, int n, int c) {
    const __attribute__((address_space(4))) Args& A = *F.a;
    LAS bf16* Vt = (LAS bf16*)F.lds; LAS float* part = (LAS float*)(F.lds + OFF_PART); LAS float* stat = (LAS float*)(F.lds + OFF_STAT);
    const size_t m0 = (size_t)n * SEQ + (size_t)c * 128; const int lane = F.lane, w = F.wave, tid = F.tid;
    if (tid < 128) {
        const f32x4* p = (const f32x4*)((const float*)(A.ws + WS_VS) + (m0 + tid) * 16);
        const f32x4 a = p[0], b = p[1], c4 = p[2], d = p[3];
        const float S1 = ((a[0] + a[2]) + (b[0] + b[2])) + ((c4[0] + c4[2]) + (d[0] + d[2])), S2 = ((a[1] + a[3]) + (b[1] + b[3])) + ((c4[1] + c4[3]) + (d[1] + d[3]));
        const float mean = S1 * (1.0f / 512.0f), var = fmaxf(S2 * (1.0f / 512.0f) - mean * mean, 0.f);
        stat[2 * tid] = mean; stat[2 * tid + 1] = __builtin_amdgcn_rsqf(var + 1e-6f);
    }
    __syncthreads();
    {
        const int cp = tid & 255, th = tid >> 8, c0 = 2 * cp;
        const float g0 = A.in[12][c0], g1 = A.in[12][c0 + 1], b0 = A.in[13][c0], b1 = A.in[13][c0 + 1];
        const bf16* zc = F.Z + (m0 + 64 * th) * NIN + 512 + c0;
        float* cv = F.out + OUT_PCV + ((size_t)n * 128 + 64 * th) * 512 + c0;
#pragma unroll 1
        for (int g32 = 0; g32 < 2; ++g32) {
            unsigned hv[32];
#pragma unroll
            for (int j = 0; j < 32; ++j) hv[j] = *(const unsigned*)(zc + (size_t)(32 * g32 + j) * NIN);
#pragma unroll
            for (int q = 0; q < 4; ++q) {
                float y0[8], y1[8];
#pragma unroll
                for (int j = 0; j < 8; ++j) { const int tt = 64 * th + 32 * g32 + 8 * q + j; const f32x2 st = *(const LAS f32x2*)(stat + 2 * tt); float lo, hi; unpack2(hv[8 * q + j], lo, hi);
                    y0[j] = (lo - st.x) * st.y * g0 + b0; y1[j] = (hi - st.x) * st.y * g1 + b1; }
                if (c == 15) {
#pragma unroll
                    for (int j = 0; j < 8; ++j) *(f32x2*)(cv + (size_t)(32 * g32 + 8 * q + j) * 512) = (f32x2){y0[j], y1[j]};
                }
                *(LAS v4u*)(Vt + c0 * VT_A + 64 * th + 32 * g32 + 8 * q) = pack8(y0);
                *(LAS v4u*)(Vt + (c0 + 1) * VT_A + 64 * th + 32 * g32 + 8 * q) = pack8(y1);
            }
        }
    }
    __syncthreads();
    {
        const int h = w, fr = lane & 15, fq = lane >> 4;
        const bf16* wbase = (const bf16*)(A.ws + WS_WSB) + (size_t)h * 128 * 128 + 8 * fq; const float* bsb = A.in[15] + h * 128;
#pragma unroll
        for (int half = 0; half < 4; ++half) {
            v4u wy[2][4]; v2u ur[2][4]; float bias[2];
#pragma unroll
            for (int q = 0; q < 2; ++q) {
                const int tb = 2 * half + q, t = tb * 16 + fr, nks = tb / 2 + 1;
#pragma unroll
                for (int ks = 0; ks < 4; ++ks) if (ks < nks) wy[q][ks] = *(const v4u*)(wbase + (size_t)t * 128 + 32 * ks);
#pragma unroll
                for (int db = 0; db < 4; ++db) ur[q][db] = *(const v2u*)(F.Z + (m0 + t) * NIN + 64 * h + 16 * db + 4 * fq);
                bias[q] = bsb[t];
            }
#pragma unroll
            for (int q = 0; q < 2; ++q) {
                const int tb = 2 * half + q, t = tb * 16 + fr, nks = tb / 2 + 1;
                bf16x8 Y[4];
#pragma unroll
                for (int ks = 0; ks < 4; ++ks) if (ks < nks) Y[ks] = as_bf16x8(wy[q][ks]);
                float ssq = 0.f;
#pragma unroll
                for (int db = 0; db < 4; ++db) {
                    f32x4 acc = {0.f, 0.f, 0.f, 0.f};
#pragma unroll
                    for (int ks = 0; ks < 4; ++ks) if (ks < nks) {
                        const bf16x8 X = *(const LAS bf16x8*)(Vt + (64 * h + 16 * db + fr) * VT_A + 32 * ks + 8 * fq);
                        acc = __builtin_amdgcn_mfma_f32_16x16x32_bf16(X, Y[ks], acc, 0, 0, 0);
                    }
                    float u0, u1, u2, u3; unpack2(ur[q][db].x, u0, u1); unpack2(ur[q][db].y, u2, u3);
                    const float a0 = u0 * (acc[0] + bias[q]), a1 = u1 * (acc[1] + bias[q]), a2 = u2 * (acc[2] + bias[q]), a3 = u3 * (acc[3] + bias[q]);
                    ssq += (a0 * a0 + a1 * a1) + (a2 * a2 + a3 * a3);
                    v2u o; o.x = cvt_pk_bf16(a0, a1); o.y = cvt_pk_bf16(a2, a3);
                    *(v2u*)(F.MIX + (m0 + t) * D + 64 * h + 16 * db + 4 * fq) = o;
                }
                ssq += __shfl_xor(ssq, 16); ssq += __shfl_xor(ssq, 32);
                if (fq == 0) part[t * 8 + h] = ssq;
            }
        }
    }
    __syncthreads();
    finalize_rows<16>(F, m0, 0, A.in[19]);
}

__device__ __forceinline__ void k_norm_rope(Frame& F, const bf16* zk, int prow, LAS bf16* krow, float* kout) {
    const __attribute__((address_space(4))) Args& A = *F.a; const float* gk = A.in[17];
    float ss = 0.f;
#pragma unroll
    for (int i = 0; i < 8; ++i) { float x[8]; unpack8(*(const v4u*)(zk + 8 * i), x);
#pragma unroll
        for (int j = 0; j < 8; ++j) ss += x[j] * x[j]; }
    const float rs = __builtin_amdgcn_rsqf(ss * (1.0f / 64.0f) + 1e-6f);
    const f32x2* tab = F.rope + prow * 32;
#pragma unroll 1
    for (int i = 0; i < 4; ++i) {
        float x1[8], x2[8], o1[8], o2[8]; unpack8(*(const v4u*)(zk + 8 * i), x1); unpack8(*(const v4u*)(zk + 32 + 8 * i), x2);
#pragma unroll
        for (int j = 0; j < 8; ++j) { const float a = x1[j] * rs * gk[8 * i + j], b = x2[j] * rs * gk[32 + 8 * i + j]; const f32x2 cs = tab[8 * i + j]; o1[j] = a * cs.x - b * cs.y; o2[j] = b * cs.x + a * cs.y; }
        *(LAS v4u*)(krow + 8 * i) = pack8(o1); *(LAS v4u*)(krow + 32 + 8 * i) = pack8(o2);
        if (kout) {
            *(f32x4*)(kout + 8 * i) = (f32x4){o1[0], o1[1], o1[2], o1[3]}; *(f32x4*)(kout + 8 * i + 4) = (f32x4){o1[4], o1[5], o1[6], o1[7]};
            *(f32x4*)(kout + 32 + 8 * i) = (f32x4){o2[0], o2[1], o2[2], o2[3]}; *(f32x4*)(kout + 32 + 8 * i + 4) = (f32x4){o2[4], o2[5], o2[6], o2[7]};
        }
        asm volatile("" ::: "memory");
    }
}
__device__ __forceinline__ void v_fill(const bf16* zv, LAS bf16* vcol  , float* vout) {
#pragma unroll 1
    for (int i = 0; i < 8; ++i) {
        const v4u raw = *(const v4u*)(zv + 8 * i); float x[8]; unpack8(raw, x);
#pragma unroll
        for (int j = 0; j < 8; ++j) vcol[(8 * i + j) * VP] = (bf16)(__float_as_uint(x[j]) >> 16);
        if (vout) { *(f32x4*)(vout + 8 * i) = (f32x4){x[0], x[1], x[2], x[3]}; *(f32x4*)(vout + 8 * i + 4) = (f32x4){x[4], x[5], x[6], x[7]}; }
        asm volatile("" ::: "memory");
    }
}

__device__ __forceinline__ void kv_fill(Frame& F, const bf16* zk, const bf16* zv, int prow, LAS bf16* krow, LAS bf16* vcol, float* kout, float* vout) {
    const Args __attribute__((address_space(4)))& A = *F.a; const float* gk = A.in[17];
    v4u rk[8], rv[8];
#pragma unroll
    for (int i = 0; i < 8; ++i) { rk[i] = *(const v4u*)(zk + 8 * i); rv[i] = *(const v4u*)(zv + 8 * i); }
    float ss = 0.f;
#pragma unroll
    for (int i = 0; i < 8; ++i) { float x[8]; unpack8(rk[i], x);
#pragma unroll
        for (int j = 0; j < 8; ++j) ss += x[j] * x[j]; }
    const float rs = __builtin_amdgcn_rsqf(ss * (1.0f / 64.0f) + 1e-6f);
    const f32x4* tab = (const f32x4*)(F.rope + prow * 32);
#pragma unroll
    for (int i = 0; i < 4; ++i) {
        float x1[8], x2[8], o1[8], o2[8]; unpack8(rk[i], x1); unpack8(rk[4 + i], x2);
        const f32x4 t0 = tab[4 * i], t1 = tab[4 * i + 1], t2 = tab[4 * i + 2], t3 = tab[4 * i + 3];
        const float cs[16] = {t0[0], t0[1], t0[2], t0[3], t1[0], t1[1], t1[2], t1[3], t2[0], t2[1], t2[2], t2[3], t3[0], t3[1], t3[2], t3[3]};
        const f32x4 ga = *(const f32x4*)(gk + 8 * i), gb = *(const f32x4*)(gk + 8 * i + 4), gc = *(const f32x4*)(gk + 32 + 8 * i), gd = *(const f32x4*)(gk + 32 + 8 * i + 4);
        const float g1[8] = {ga[0], ga[1], ga[2], ga[3], gb[0], gb[1], gb[2], gb[3]}, g2[8] = {gc[0], gc[1], gc[2], gc[3], gd[0], gd[1], gd[2], gd[3]};
#pragma unroll
        for (int j = 0; j < 8; ++j) { const float a = x1[j] * rs * g1[j], b = x2[j] * rs * g2[j]; o1[j] = a * cs[2 * j] - b * cs[2 * j + 1]; o2[j] = b * cs[2 * j] + a * cs[2 * j + 1]; }
        *(LAS v4u*)(krow + 8 * i) = pack8(o1); *(LAS v4u*)(krow + 32 + 8 * i) = pack8(o2);
        if (kout) {
            *(f32x4*)(kout + 8 * i) = (f32x4){o1[0], o1[1], o1[2], o1[3]}; *(f32x4*)(kout + 8 * i + 4) = (f32x4){o1[4], o1[5], o1[6], o1[7]};
            *(f32x4*)(kout + 32 + 8 * i) = (f32x4){o2[0], o2[1], o2[2], o2[3]}; *(f32x4*)(kout + 32 + 8 * i + 4) = (f32x4){o2[4], o2[5], o2[6], o2[7]};
        }
        asm volatile("" ::: "memory");
    }
#pragma unroll
    for (int i = 0; i < 8; ++i) {
        const unsigned wv[4] = {rv[i].x, rv[i].y, rv[i].z, rv[i].w};
#pragma unroll
        for (int q = 0; q < 4; ++q) { vcol[(8 * i + 2 * q) * VP] = (bf16)(wv[q] & 0xffffu); vcol[(8 * i + 2 * q + 1) * VP] = (bf16)(wv[q] >> 16); }
        if (vout) { float x[8]; unpack8(rv[i], x); *(f32x4*)(vout + 8 * i) = (f32x4){x[0], x[1], x[2], x[3]}; *(f32x4*)(vout + 8 * i + 4) = (f32x4){x[4], x[5], x[6], x[7]}; }
    }
}

struct QRaw { v4u q0, q1; f32x4 t[4]; };
__device__ __forceinline__ QRaw q_load(Frame& F, size_t mrow, int hq, int prow) {
    const int fq = F.lane >> 4; QRaw r;
    const bf16* zq = F.Z + mrow * NIN + 1024 + 64 * hq + 8 * fq;
    r.q0 = *(const v4u*)zq; r.q1 = *(const v4u*)(zq + 32);
    const f32x4* tab = (const f32x4*)(F.rope + prow * 32 + 8 * fq);
#pragma unroll
    for (int i = 0; i < 4; ++i) r.t[i] = tab[i];
    return r;
}
__device__ __forceinline__ void attn_qblock(Frame& F, const QRaw& qr, const float (&gq1)[8], const float (&gq2)[8], const LAS bf16* Kl, const LAS bf16* Vl, LAS float* partp, size_t mrow, int tq, int tq_lo, int tq_hi, int hq, float sink_nat, int kb0, int jmin) {
    const int fq = F.lane >> 4;
    float x1[8], x2[8]; unpack8(qr.q0, x1); unpack8(qr.q1, x2);
    float ss = 0.f;
#pragma unroll
    for (int j = 0; j < 8; ++j) ss += x1[j] * x1[j] + x2[j] * x2[j];
    ss += __shfl_xor(ss, 16); ss += __shfl_xor(ss, 32);
    const float rs = (0.125f * 1.4426950408889634f) * __builtin_amdgcn_rsqf(ss * (1.0f / 64.0f) + 1e-6f);
#pragma unroll
    for (int j = 0; j < 8; ++j) { const float a = x1[j] * rs * gq1[j], b = x2[j] * rs * gq2[j]; const float cc = qr.t[j >> 1][2 * (j & 1)], sn = qr.t[j >> 1][2 * (j & 1) + 1]; x1[j] = a * cc - b * sn; x2[j] = b * cc + a * sn; }
    const bf16x8 Yq0 = as_bf16x8(pack8(x1)), Yq1 = as_bf16x8(pack8(x2));
    f32x4 S[10];
#pragma unroll
    for (int kk = 0; kk < 10; ++kk) {
        const LAS bf16* kp = Kl + (16 * (kb0 + kk) + (F.lane & 15)) * KP + 8 * fq;
        const bf16x8 X0 = *(const LAS bf16x8*)kp, X1 = *(const LAS bf16x8*)(kp + 32);
        f32x4 a = {0.f, 0.f, 0.f, 0.f};
        a = __builtin_amdgcn_mfma_f32_16x16x32_bf16(X0, Yq0, a, 0, 0, 0);
        a = __builtin_amdgcn_mfma_f32_16x16x32_bf16(X1, Yq1, a, 0, 0, 0);
        S[kk] = a;
    }
    const float sink = sink_nat * 1.4426950408889634f;
    float mx = sink;
#pragma unroll
    for (int kk = 0; kk < 10; ++kk) {
        const int jb = 16 * (kb0 + kk);
        if (jb > tq_hi && jb + 15 <= tq_lo + 128 && jb >= jmin) {
#pragma unroll
            for (int v = 0; v < 4; ++v) mx = fmaxf(mx, S[kk][v]);
        } else {
#pragma unroll
            for (int v = 0; v < 4; ++v) { const int j = jb + 4 * fq + v; const bool ok = (j > tq) && (j <= tq + 128) && (j >= jmin); S[kk][v] = ok ? S[kk][v] : -INFINITY; mx = fmaxf(mx, S[kk][v]); }
        }
    }
    mx = fmaxf(mx, __shfl_xor(mx, 16)); mx = fmaxf(mx, __shfl_xor(mx, 32));
    float sum = 0.f;
#pragma unroll
    for (int kk = 0; kk < 10; ++kk)
#pragma unroll
        for (int v = 0; v < 4; ++v) { const float p = __builtin_amdgcn_exp2f(S[kk][v] - mx); S[kk][v] = p; sum += p; }
    sum += __shfl_xor(sum, 16); sum += __shfl_xor(sum, 32);
    const float inv = __builtin_amdgcn_rcpf(sum + __builtin_amdgcn_exp2f(sink - mx));
    bf16x8 Yp[5];
#pragma unroll
    for (int i = 0; i < 5; ++i) { v4u w; w.x = cvt_pk_bf16(S[2 * i][0], S[2 * i][1]); w.y = cvt_pk_bf16(S[2 * i][2], S[2 * i][3]); w.z = cvt_pk_bf16(S[2 * i + 1][0], S[2 * i + 1][1]); w.w = cvt_pk_bf16(S[2 * i + 1][2], S[2 * i + 1][3]); Yp[i] = as_bf16x8(w); }
    float ssq = 0.f;
#pragma unroll
    for (int db = 0; db < 4; ++db) {
        f32x4 o = {0.f, 0.f, 0.f, 0.f};
#pragma unroll
        for (int i = 0; i < 5; ++i) {
            const LAS bf16* vp = Vl + (16 * db + (F.lane & 15)) * VP + 16 * (kb0 + 2 * i) + 4 * fq;
            const v2u lo = *(const LAS v2u*)vp, hi = *(const LAS v2u*)(vp + 16);
            v4u xw; xw.x = lo.x; xw.y = lo.y; xw.z = hi.x; xw.w = hi.y;
            o = __builtin_amdgcn_mfma_f32_16x16x32_bf16(as_bf16x8(xw), Yp[i], o, 0, 0, 0);
        }
        o = o * inv; ssq += (o[0] * o[0] + o[1] * o[1]) + (o[2] * o[2] + o[3] * o[3]);
        v2u ow; ow.x = cvt_pk_bf16(o[0], o[1]); ow.y = cvt_pk_bf16(o[2], o[3]);
        *(v2u*)(F.MIX + mrow * D + 512 + 64 * hq + 16 * db + 4 * fq) = ow;
    }
    ssq += __shfl_xor(ssq, 16); ssq += __shfl_xor(ssq, 32);
    if (fq == 0) *partp = ssq;
}

__device__ __forceinline__ void mix_prompt_B(Frame& F, int n, int c) {
    const __attribute__((address_space(4))) Args& A = *F.a;
    LAS bf16* Kl = (LAS bf16*)F.lds; LAS bf16* Vl = (LAS bf16*)(F.lds + 2 * 256 * KP * 2); LAS float* part = (LAS float*)(F.lds + OFF_PART);
    const size_t m0 = (size_t)n * SEQ + (size_t)c * 128; const int lane = F.lane, w = F.wave, tid = F.tid;
    {
        const int kv = tid >> 8, j = tid & 255;
        LAS bf16* krow = Kl + (kv * 256 + j) * KP; LAS bf16* vcol = Vl + kv * 64 * VP + j;
        if (c == 0 && j < 128) {
#pragma unroll
            for (int i = 0; i < 8; ++i) *(LAS v4u*)(krow + 8 * i) = (v4u){0u, 0u, 0u, 0u};
            for (int d = 0; d < 64; ++d) vcol[d * VP] = 0;
        } else {
            const size_t mk = m0 - 128 + j; const bool tail = (c == 15 && j >= 128);
            float* kout = tail ? F.out + OUT_PKW + (((size_t)n * 128 + (j - 128)) * 2 + kv) * 64 : nullptr;
            float* vout = tail ? F.out + OUT_PVW + (((size_t)n * 128 + (j - 128)) * 2 + kv) * 64 : nullptr;
            kv_fill(F, F.Z + mk * NIN + 1536 + 64 * kv, F.Z + mk * NIN + 1664 + 64 * kv, (c - 1) * 128 + j, krow, vcol, kout, vout);
        }
    }
    __syncthreads();
    {
        const int h = w, kv = h >> 2, fr = lane & 15, fq = lane >> 4;
        float gq1[8], gq2[8];
#pragma unroll
        for (int j = 0; j < 8; ++j) { gq1[j] = A.in[16][8 * fq + j]; gq2[j] = A.in[16][32 + 8 * fq + j]; }
        const float sink = A.in[18][h];
        QRaw cur = q_load(F, m0 + fr, h, c * 128 + fr);
#pragma unroll 1
        for (int qb = 0; qb < 8; ++qb) {
            const int tq = 16 * qb + fr, tn = (qb < 7) ? tq + 16 : tq;
            const QRaw nxt = q_load(F, m0 + tn, h, c * 128 + tn);
            attn_qblock(F, cur, gq1, gq2, Kl + kv * 256 * KP, Vl + kv * 64 * VP, part + tq * 8 + h, m0 + tq, tq, 16 * qb, 16 * qb + 15, h, sink, qb & ~1, c == 0 ? 128 : 0);
            cur = nxt;
        }
    }
    __syncthreads();
    finalize_rows<16>(F, m0, 512, A.in[20]);
}

__device__ __forceinline__ void mix_sample_A(Frame& F, int n) {
    const __attribute__((address_space(4))) Args& A = *F.a;
    LAS float* red = (LAS float*)(F.lds + OFF_RED);
    const size_t m0 = (size_t)MP + (size_t)n * 8; const int lane = F.lane, w = F.wave, tid = F.tid;
    {
        const int col = tid, h = col >> 6;
        float v[8];
#pragma unroll
        for (int s = 0; s < 8; ++s) v[s] = bf2f(F.Z[(m0 + s) * NIN + 512 + col]);
        float my_mean, my_rstd;
        {
            const f32x4* p = (const f32x4*)((const float*)(A.ws + WS_VS) + (m0 + (lane & 7)) * 16);
            const f32x4 a4 = p[0], b4 = p[1], c4 = p[2], d4 = p[3];
            const float S1 = ((a4[0] + a4[2]) + (b4[0] + b4[2])) + ((c4[0] + c4[2]) + (d4[0] + d4[2])), S2 = ((a4[1] + a4[3]) + (b4[1] + b4[3])) + ((c4[1] + c4[3]) + (d4[1] + d4[3]));
            my_mean = S1 * (1.0f / 512.0f); my_rstd = __builtin_amdgcn_rsqf(fmaxf(S2 * (1.0f / 512.0f) - my_mean * my_mean, 0.f) + 1e-6f);
        }
        const float gc = A.in[12][col], bc = A.in[13][col];
#pragma unroll
        for (int s = 0; s < 8; ++s) {
            const float mean = __shfl(my_mean, s), rstd = __shfl(my_rstd, s);
            v[s] = (v[s] - mean) * rstd * gc + bc;
            F.out[OUT_SCV + ((size_t)n * 8 + s) * 512 + col] = v[s];
        }
        float a[8];
#pragma unroll
        for (int t = 0; t < 8; ++t) {
            const float* wr = A.in[14] + ((size_t)(h * 128 + t)) * 128; float mixed = A.in[15][h * 128 + t];
#pragma unroll
            for (int s = 0; s < 8; ++s) if (s <= t) mixed += wr[s] * v[s];
            a[t] = bf2f(F.Z[(m0 + t) * NIN + col]) * mixed;
            const float q = wave_sum(a[t] * a[t]); if (lane == 0) red[w * 16 + t] = q;
        }
        __syncthreads();
        const float go = A.in[19][col];
#pragma unroll
        for (int t = 0; t < 8; ++t) {
            float q = 0.f;
#pragma unroll
            for (int ww = 0; ww < 8; ++ww) q += red[ww * 16 + t];
            const float rs = __builtin_amdgcn_rsqf(q * (1.0f / 512.0f) + 1e-6f);
            F.MIX[(m0 + t) * D + col] = (bf16)(cvt_pk_bf16(a[t] * rs * go, 0.f) & 0xffffu);
        }
    }
}

__device__ __forceinline__ void mix_sample_B(Frame& F, int n) {
    const __attribute__((address_space(4))) Args& A = *F.a;
    LAS bf16* Kl = (LAS bf16*)F.lds; LAS bf16* Vl = (LAS bf16*)(F.lds + 2 * 256 * KP * 2); LAS float* part = (LAS float*)(F.lds + OFF_PART);
    const size_t m0 = (size_t)MP + (size_t)n * 8; const int lane = F.lane, w = F.wave, tid = F.tid;
    const int fr_q = lane & 15, fq_q = lane >> 4, hq_q = 2 * (w & 3) + (fr_q >> 3), t_q = fr_q & 7;
    const QRaw qr_pre = q_load(F, m0 + t_q, hq_q, 2048 + t_q);
    float gq1[8], gq2[8];
#pragma unroll
    for (int j = 0; j < 8; ++j) { gq1[j] = A.in[16][8 * fq_q + j]; gq2[j] = A.in[16][32 + 8 * fq_q + j]; }
    const float sink_q = A.in[18][hq_q];
    {
        const int kv = tid >> 8, j = (tid & 255) >> 1, hf = tid & 1;
        LAS bf16* krow = Kl + (kv * 256 + j) * KP + 32 * hf; LAS bf16* vcol = Vl + kv * 64 * VP + (32 * hf) * VP + j;
        const float* ck = A.in[4] + (((size_t)n * 128 + j) * 2 + kv) * 64 + 32 * hf; const float* cvp = A.in[5] + (((size_t)n * 128 + j) * 2 + kv) * 64 + 32 * hf;
        float* ko = F.out + OUT_SKW + (((size_t)n * 128 + (j - 8)) * 2 + kv) * 64 + 32 * hf; float* vo = F.out + OUT_SVW + (((size_t)n * 128 + (j - 8)) * 2 + kv) * 64 + 32 * hf;
        f32x4 kr[8], vr[8];
#pragma unroll
        for (int i = 0; i < 8; ++i) { kr[i] = *(const f32x4*)(ck + 4 * i); vr[i] = *(const f32x4*)(cvp + 4 * i); }
#pragma unroll
        for (int i = 0; i < 4; ++i) {
            const f32x4 k0 = kr[2 * i], k1 = kr[2 * i + 1], v0 = vr[2 * i], v1 = vr[2 * i + 1];
            v4u kw; kw.x = cvt_pk_bf16(k0[0], k0[1]); kw.y = cvt_pk_bf16(k0[2], k0[3]); kw.z = cvt_pk_bf16(k1[0], k1[1]); kw.w = cvt_pk_bf16(k1[2], k1[3]);
            *(LAS v4u*)(krow + 8 * i) = kw;
            const unsigned va = cvt_pk_bf16(v0[0], v0[1]), vb = cvt_pk_bf16(v0[2], v0[3]), vc = cvt_pk_bf16(v1[0], v1[1]), vd = cvt_pk_bf16(v1[2], v1[3]);
            vcol[(8 * i + 0) * VP] = (bf16)(va & 0xffffu); vcol[(8 * i + 1) * VP] = (bf16)(va >> 16); vcol[(8 * i + 2) * VP] = (bf16)(vb & 0xffffu); vcol[(8 * i + 3) * VP] = (bf16)(vb >> 16);
            vcol[(8 * i + 4) * VP] = (bf16)(vc & 0xffffu); vcol[(8 * i + 5) * VP] = (bf16)(vc >> 16); vcol[(8 * i + 6) * VP] = (bf16)(vd & 0xffffu); vcol[(8 * i + 7) * VP] = (bf16)(vd >> 16);
            if (j >= 8) { *(f32x4*)(ko + 8 * i) = k0; *(f32x4*)(ko + 8 * i + 4) = k1; *(f32x4*)(vo + 8 * i) = v0; *(f32x4*)(vo + 8 * i + 4) = v1; }
        }
        if (tid < 48) {
            const int kz = tid / 24, jz = 136 + tid % 24;
            LAS bf16* kz_row = Kl + (kz * 256 + jz) * KP; LAS bf16* vz = Vl + kz * 64 * VP + jz;
#pragma unroll
            for (int i = 0; i < 8; ++i) *(LAS v4u*)(kz_row + 8 * i) = (v4u){0u, 0u, 0u, 0u};
            for (int d = 0; d < 64; ++d) vz[d * VP] = 0;
        }
    }
    if (w == 7) {
        const int task = lane >> 2, q = lane & 3, t = task & 7, kv2 = task >> 3; const size_t mk = m0 + t;
        const bf16* zk = F.Z + mk * NIN + 1536 + 64 * kv2 + 8 * q; const bf16* zv = F.Z + mk * NIN + 1664 + 64 * kv2 + 8 * q;
        const v4u k0 = *(const v4u*)zk, k1 = *(const v4u*)(zk + 32), v0 = *(const v4u*)zv, v1 = *(const v4u*)(zv + 32);
        const f32x4* tab = (const f32x4*)(F.rope + (2048 + t) * 32 + 8 * q); f32x4 tt[4];
#pragma unroll
        for (int i = 0; i < 4; ++i) tt[i] = tab[i];
        const float* gk = A.in[17]; float g1[8], g2[8];
#pragma unroll
        for (int j2 = 0; j2 < 8; ++j2) { g1[j2] = gk[8 * q + j2]; g2[j2] = gk[32 + 8 * q + j2]; }
        float x1[8], x2[8], o1[8], o2[8]; unpack8(k0, x1); unpack8(k1, x2);
        float ss = 0.f;
#pragma unroll
        for (int j2 = 0; j2 < 8; ++j2) ss += x1[j2] * x1[j2] + x2[j2] * x2[j2];
        ss += __shfl_xor(ss, 1); ss += __shfl_xor(ss, 2);
        const float rs = __builtin_amdgcn_rsqf(ss * (1.0f / 64.0f) + 1e-6f);
#pragma unroll
        for (int j2 = 0; j2 < 8; ++j2) { const float a = x1[j2] * rs * g1[j2], b = x2[j2] * rs * g2[j2]; const float cc = tt[j2 >> 1][2 * (j2 & 1)], sn = tt[j2 >> 1][2 * (j2 & 1) + 1]; o1[j2] = a * cc - b * sn; o2[j2] = b * cc + a * sn; }
        LAS bf16* krow = Kl + (kv2 * 256 + 128 + t) * KP;
        *(LAS v4u*)(krow + 8 * q) = pack8(o1); *(LAS v4u*)(krow + 32 + 8 * q) = pack8(o2);
        float* ko = F.out + OUT_SKW + (((size_t)n * 128 + (120 + t)) * 2 + kv2) * 64; float* vo = F.out + OUT_SVW + (((size_t)n * 128 + (120 + t)) * 2 + kv2) * 64;
        *(f32x4*)(ko + 8 * q) = (f32x4){o1[0], o1[1], o1[2], o1[3]}; *(f32x4*)(ko + 8 * q + 4) = (f32x4){o1[4], o1[5], o1[6], o1[7]};
        *(f32x4*)(ko + 32 + 8 * q) = (f32x4){o2[0], o2[1], o2[2], o2[3]}; *(f32x4*)(ko + 32 + 8 * q + 4) = (f32x4){o2[4], o2[5], o2[6], o2[7]};
        LAS bf16* vcol = Vl + kv2 * 64 * VP + 128 + t;
        float y1[8], y2[8]; unpack8(v0, y1); unpack8(v1, y2);
#pragma unroll
        for (int e = 0; e < 8; ++e) { vcol[(8 * q + e) * VP] = (bf16)(__float_as_uint(y1[e]) >> 16); vcol[(32 + 8 * q + e) * VP] = (bf16)(__float_as_uint(y2[e]) >> 16); }
        *(f32x4*)(vo + 8 * q) = (f32x4){y1[0], y1[1], y1[2], y1[3]}; *(f32x4*)(vo + 8 * q + 4) = (f32x4){y1[4], y1[5], y1[6], y1[7]};
        *(f32x4*)(vo + 32 + 8 * q) = (f32x4){y2[0], y2[1], y2[2], y2[3]}; *(f32x4*)(vo + 32 + 8 * q + 4) = (f32x4){y2[4], y2[5], y2[6], y2[7]};
    }
    __syncthreads();
    if (w < 4) {
        const int hq = hq_q, t = t_q, kv = w >> 1;
        attn_qblock(F, qr_pre, gq1, gq2, Kl + kv * 256 * KP, Vl + kv * 64 * VP, part + t * 8 + hq, m0 + t, t, 0, 7, hq, sink_q, 0, 0);
    }
    __syncthreads();
    finalize_rows<1>(F, m0, 512, A.in[20]);
}

__device__ __forceinline__ void p4_mixer(Frame& F) {
    const int b = blockIdx.x, G = F.G;
#ifndef NO_A
    for (int it = b; it < 128; it += G) { __syncthreads(); mix_prompt_A(F, it >> 4, it & 15); }
#endif
    asm volatile("" ::: "memory");
#ifndef NO_B
    for (int it = b + ((128 - b + G * 64) / G) * 0; it < 256; it += G) { if (it >= 128) { __syncthreads(); mix_prompt_B(F, (it - 128) >> 4, (it - 128) & 15); } }
#endif
    asm volatile("" ::: "memory");
#ifndef NO_S
    for (int it = b; it < 128; it += G) { __syncthreads(); mix_sample_B(F, it); }
    asm volatile("" ::: "memory");
    for (int it = b; it < 256; it += G) { if (it >= 128) { __syncthreads(); mix_sample_A(F, it - 128); } }
#endif
}

#define XB_TMO      128
#define XB_XCNT(j)  (256  + 64 * (j))
#define XB_XSUB(j)  (1280 + 64 * (j))
#define XB_XGEN(j)  (2304 + 64 * (j))
#define XB_TOP      3328
#define XB_TOPGEN   3392
#define XCD_BAR_WORDS 3456
#define XB_SPIN_CAP (1u << 18)

__device__ __forceinline__ unsigned xb_ld(unsigned* p)              { return __hip_atomic_load(p, __ATOMIC_RELAXED, __HIP_MEMORY_SCOPE_AGENT); }
__device__ __forceinline__ unsigned xb_add(unsigned* p, unsigned v) { return __hip_atomic_fetch_add(p, v, __ATOMIC_RELAXED, __HIP_MEMORY_SCOPE_AGENT); }
__device__ __forceinline__ unsigned xb_xcc_id() { return (unsigned)__builtin_amdgcn_s_getreg((3 << 11) | 20) & 0xFu; }
#define XB_SPIN(cond, bar) do { unsigned _sp = 0; while (cond) { __builtin_amdgcn_s_sleep(1); \
    if ((++_sp & 255u) == 0u) { if (xb_ld(&(bar)[XB_TMO])) break; if (_sp > XB_SPIN_CAP) { atomicAdd(&(bar)[XB_TMO], 1u); break; } } } } while (0)

struct XcdBarrier {
    unsigned* bar; unsigned x;
    volatile LAS unsigned* st;
};

__device__ __forceinline__ XcdBarrier xcd_barrier_post(unsigned* bar, volatile LAS unsigned* st) {
    XcdBarrier b; b.bar = bar; b.x = xb_xcc_id(); b.st = st;
    if (threadIdx.x == 0) (void)xb_add(&bar[XB_XCNT(b.x)], 1u);
    return b;
}
__device__ __forceinline__ void xcd_barrier_complete(unsigned* bar, unsigned x, unsigned& nloc, unsigned& nx) {
    const unsigned G = gridDim.x * gridDim.y * gridDim.z;
    unsigned sum, cnt, mine, sp = 0u;
    for (;;) {
        sum = 0u; cnt = 0u; mine = 0u;
#pragma unroll
        for (unsigned j = 0; j < 16; ++j) { const unsigned c = xb_ld(&bar[XB_XCNT(j)]); sum += c; cnt += (c > 0u) ? 1u : 0u; mine = (j == x) ? c : mine; }
        if (sum == G) break;
        __builtin_amdgcn_s_sleep(1);
        if ((++sp & 255u) == 0u) { if (xb_ld(&bar[XB_TMO])) break; if (sp > XB_SPIN_CAP) { atomicAdd(&bar[XB_TMO], 1u); break; } }
    }
    nloc = mine > 0u ? mine : 1u; nx = cnt > 0u ? cnt : 1u;
}

__device__ __forceinline__ void xcd_barrier(const XcdBarrier& b) {
    asm volatile("s_waitcnt vmcnt(0)" ::: "memory");
    __syncthreads();
    if (threadIdx.x == 0) {
        unsigned* bar = b.bar;
        __builtin_amdgcn_s_waitcnt(0);
        unsigned nloc = b.st[0], nx = b.st[1];
        if (nloc == 0u) { xcd_barrier_complete(bar, b.x, nloc, nx); b.st[0] = nloc; b.st[1] = nx; }
        const unsigned old = xb_add(&bar[XB_XSUB(b.x)], 1u);
        const unsigned gen = old / nloc;
        if (old + 1u == (gen + 1u) * nloc) {
            __builtin_amdgcn_fence(__ATOMIC_RELEASE, "agent");
            asm volatile("s_waitcnt vmcnt(0)" ::: "memory");
            const unsigned og = xb_add(&bar[XB_TOP], 1u);
            const unsigned tg = og / nx;
            if (og + 1u == (tg + 1u) * nx) xb_add(&bar[XB_TOPGEN], 1u);
            else XB_SPIN(xb_ld(&bar[XB_TOPGEN]) == tg, bar);
            __builtin_amdgcn_fence(__ATOMIC_ACQUIRE, "agent");
            asm volatile("s_waitcnt vmcnt(0)" ::: "memory");
        } else {
            XB_SPIN(xb_ld(&bar[XB_TOPGEN]) == gen, bar);
            __builtin_amdgcn_fence(__ATOMIC_ACQUIRE, "agent");
            asm volatile("s_waitcnt vmcnt(0)" ::: "memory");
        }
    }
    __syncthreads();
}

template <class Elem>
__device__ __forceinline__ void gemm_small64(LAS unsigned char* lds, const bf16* A, const bf16* Bt, int K, int r0, int c0, const Elem& E) {
    int tid_ = threadIdx.x; asm volatile("" : "+v"(tid_));
    const int tid = tid_, lane = tid & 63, w = __builtin_amdgcn_readfirstlane(tid >> 6), fr = lane & 15, fq = lane >> 4;
    const int kw = K >> 3, k0 = w * kw;
    f32x4 acc[4][4];
#pragma unroll
    for (int i = 0; i < 4; ++i)
#pragma unroll
        for (int j = 0; j < 4; ++j) acc[i][j] = (f32x4){0.f, 0.f, 0.f, 0.f};
    const bf16* ap = A + (size_t)(r0 + fr) * K + k0 + 8 * fq;
    const bf16* bp = Bt + (size_t)(c0 + fr) * K + k0 + 8 * fq;
    const size_t s16 = (size_t)16 * K;
#pragma unroll 4
    for (int ks = 0; ks < kw; ks += 32) {
        bf16x8 a[4], b[4];
#pragma unroll
        for (int i = 0; i < 4; ++i) { a[i] = *(const bf16x8*)(ap + i * s16 + ks); b[i] = *(const bf16x8*)(bp + i * s16 + ks); }
#pragma unroll
        for (int rb = 0; rb < 4; ++rb)
#pragma unroll
            for (int cb = 0; cb < 4; ++cb) acc[rb][cb] = __builtin_amdgcn_mfma_f32_16x16x32_bf16(b[cb], a[rb], acc[rb][cb], 0, 0, 0);
    }
    LAS float* P = (LAS float*)lds;
#pragma unroll
    for (int rb = 0; rb < 4; ++rb)
#pragma unroll
        for (int cb = 0; cb < 4; ++cb) *(LAS f32x4*)(P + (w * 64 + rb * 16 + fr) * 68 + cb * 16 + 4 * fq) = acc[rb][cb];
    __syncthreads();
    const int row = tid >> 3, c8 = (tid & 7) * 8;
    f32x4 v0 = {0.f, 0.f, 0.f, 0.f}, v1 = {0.f, 0.f, 0.f, 0.f};
#pragma unroll
    for (int ww = 0; ww < 8; ++ww) { v0 += *(const LAS f32x4*)(P + (ww * 64 + row) * 68 + c8); v1 += *(const LAS f32x4*)(P + (ww * 64 + row) * 68 + c8 + 4); }
    float ss = E.elem8(r0 + row, c0 + c8, v0, v1);
    if (Elem::HAS_SS) { ss += __shfl_xor(ss, 1); ss += __shfl_xor(ss, 2); ss += __shfl_xor(ss, 4); if ((tid & 7) == 0) E.row_ss(r0 + row, c0 >> 6, ss); }
    __syncthreads();
}
struct ElemRes {
    static constexpr bool HAS_SS = true;
    bf16* XB; float* SS; float alpha;
    __device__ __forceinline__ float elem8(int r, int c, f32x4 a0, f32x4 a1) const {
        bf16* xp = XB + (size_t)r * D + c; float x[8]; unpack8(*(const v4u*)xp, x);
#pragma unroll
        for (int j = 0; j < 4; ++j) { x[j] += a0[j] * alpha; x[4 + j] += a1[j] * alpha; }
        *(v4u*)xp = pack8(x);
        float ss = 0.f;
#pragma unroll
        for (int j = 0; j < 8; ++j) ss += x[j] * x[j];
        return ss;
    }
    __device__ __forceinline__ void row_ss(int r, int slot, float ss) const { SS[(size_t)r * 16 + slot] = ss; }
};
struct ElemPle {
    static constexpr bool HAS_SS = false;
    const bf16* XB; const bf16* P; float* Y; const float* SS;
    __device__ __forceinline__ float elem8(int r, int c, f32x4 a0, f32x4 a1) const {
        const float rs = pg8::row_rs(SS, r); const size_t off = (size_t)r * D + c;
        float x[8], p[8]; unpack8(*(const v4u*)(XB + off), x); unpack8(*(const v4u*)(P + off), p); f32x4 o0, o1;
#pragma unroll
        for (int j = 0; j < 4; ++j) { o0[j] = x[j] + __builtin_amdgcn_rcpf(1.0f + __expf(-a0[j] * rs)) * p[j]; o1[j] = x[4 + j] + __builtin_amdgcn_rcpf(1.0f + __expf(-a1[j] * rs)) * p[4 + j]; }
        *(f32x4*)(Y + off) = o0; *(f32x4*)(Y + off + 4) = o1; return 0.f;
    }
    __device__ __forceinline__ void row_ss(int, int, float) const {}
};
struct ElemBf {
    static constexpr bool HAS_SS = false;
    bf16* P;
    __device__ __forceinline__ float elem8(int r, int c, f32x4 a0, f32x4 a1) const { float x[8] = {a0[0], a0[1], a0[2], a0[3], a1[0], a1[1], a1[2], a1[3]}; *(v4u*)(P + (size_t)r * D + c) = pack8(x); return 0.f; }
    __device__ __forceinline__ void row_ss(int, int, float) const {}
};
template <class Elem>
__device__ __forceinline__ void gemm_sample_rows(Frame& F, const bf16* A, const bf16* Bt, int K, const Elem& E) {
    for (int st = blockIdx.x; st < 256; st += F.G) gemm_small64<Elem>(F.lds, A, Bt, K, MP + 64 * (st >> 4), 64 * (st & 15), E);
}

__global__ void __launch_bounds__(NWAVES * 64, 2) fwd_megakernel(Args args) {
    extern __shared__ __attribute__((aligned(16))) unsigned char lds_raw[];
    cg::grid_group grid = cg::this_grid();
    Frame F;
    F.lds = (LAS unsigned char*)lds_raw; F.tid = threadIdx.x; F.lane = F.tid & 63; F.wave = __builtin_amdgcn_readfirstlane(F.tid >> 6); F.G = gridDim.x;
    const __attribute__((address_space(4))) Args* KA = (const __attribute__((address_space(4))) Args*)__builtin_amdgcn_kernarg_segment_ptr();
    F.a = KA; F.out = KA->out;
    unsigned char* ws = KA->ws;
    F.Z = (bf16*)(ws + WS_Z); F.MIX = (bf16*)(ws + WS_MIX); F.rope = (const f32x2*)(ws + WS_ROPE);
    bf16* XG = (bf16*)(ws + WS_XB); bf16* ACT = (bf16*)(ws + WS_ACT); bf16* PRJ = (bf16*)(ws + WS_PRJ); float* SS = (float*)(ws + WS_SS);
    const int lo = KA->ph_lo, hi = KA->ph_hi;
    const bool spread = (F.G == 256);
#ifndef PH_MASK
#define PH_MASK 0x1ff
#endif
#define IN(k) (((PH_MASK >> (k)) & 1) && lo <= (k) && (k) < hi)
    if (F.tid < 64) ((LAS unsigned*)(F.lds + OFF_MISC))[F.tid] = 0u;
    __syncthreads();
    const XcdBarrier bar = xcd_barrier_post((unsigned*)(ws + WS_CTL), (volatile LAS unsigned*)(F.lds + OFF_MISC));
    if (lo > 1000) grid.sync();
#define SEAM(k) do { if (IN(k) && IN((k) + 1)) xcd_barrier(bar); } while (0)
    if (IN(0)) { p0_prologue(F); } SEAM(0);
    if (IN(1)) {
        pg8::Gemm g{XG, (const bf16*)(ws + WS_W1T), MT, 2 * FF, D}; pg8::StaticOrder S; S.init(MT, 2 * FF, F.G, (int)blockIdx.x);
        pg8::EpiAct E{ACT, SS, FF};
        pg8::gemm_phase<pg8::EpiAct, pg8::StaticOrder, true, true>(F.lds, g, S, E);
        if (spread) {
            const int k = (int)blockIdx.x - 216; pg8::RangeOrder R{k >= 0 ? 2 * k : 0, k >= 0 ? 2 * k + 2 : 0};
            pg8::Gemm gp{(const bf16*)(ws + WS_PE), (const bf16*)(ws + WS_WPP), MP, D, DPLE}; pg8::EpiBf Ep{PRJ};
            pg8::gemm_phase<pg8::EpiBf, pg8::RangeOrder, true, true>(F.lds, gp, R, Ep);
        }
    } SEAM(1);
    if (IN(2)) {
        pg8::Gemm g{ACT, (const bf16*)(ws + WS_W1D), MP, D, FF}; pg8::StaticOrder S; S.init(MP, D, F.G, (int)blockIdx.x);
        pg8::EpiRes E{XG, SS, 0.5f};
        pg8::gemm_phase<pg8::EpiRes, pg8::StaticOrder, true, true>(F.lds, g, S, E);
        ElemRes Es{XG, SS, 0.5f};
        gemm_sample_rows<ElemRes>(F, ACT, (const bf16*)(ws + WS_W1D), FF, Es);
    } SEAM(2);
    if (IN(3)) {
        { pg8::Gemm g{XG, (const bf16*)(ws + WS_WIN), MT, NIN, D}; pg8::StaticOrder S; S.init(MT, NIN, F.G, (int)blockIdx.x);
          pg8::EpiZ E{F.Z, SS, NIN, 4, (float*)(ws + WS_VS)};
          pg8::gemm_phase<pg8::EpiZ, pg8::StaticOrder, true, true>(F.lds, g, S, E); }
        if (spread) {
            const int k = (int)blockIdx.x - 220; const int f = k < 0 ? 0 : (k < 24 ? 160 + 3 * k : 232 + 2 * (k - 24)), n = k < 0 ? 0 : (k < 24 ? 3 : 2); pg8::RangeOrder R{f, f + n};
            pg8::Gemm gp{(const bf16*)(ws + WS_PE), (const bf16*)(ws + WS_WPP), MP, D, DPLE}; pg8::EpiBf Ep{PRJ};
            pg8::gemm_phase<pg8::EpiBf, pg8::RangeOrder, true, true>(F.lds, gp, R, Ep);
        }
    } SEAM(3);
    if (IN(4)) { p4_mixer(F); } SEAM(4);
    if (IN(5)) {
        pg8::Gemm g{F.MIX, (const bf16*)(ws + WS_WO), MP, D, D}; pg8::StaticOrder S; S.init(MP, D, F.G, (int)blockIdx.x);
        pg8::EpiRes E{XG, SS, 1.0f};
        pg8::gemm_phase<pg8::EpiRes, pg8::StaticOrder, true, true>(F.lds, g, S, E);
        ElemRes Es{XG, SS, 1.0f};
        gemm_sample_rows<ElemRes>(F, F.MIX, (const bf16*)(ws + WS_WO), D, Es);
    } SEAM(5);
    if (IN(6)) {
        pg8::Gemm g{XG, (const bf16*)(ws + WS_W2T), MT, 2 * FF, D}; pg8::StaticOrder S; S.init(MT, 2 * FF, F.G, (int)blockIdx.x);
        pg8::EpiAct E{ACT, SS, FF};
        pg8::gemm_phase<pg8::EpiAct, pg8::StaticOrder, true, true>(F.lds, g, S, E);
        if (spread) {
            const int k = (int)blockIdx.x - 216; pg8::RangeOrder R{k >= 0 ? 80 + 2 * k : 0, k >= 0 ? 80 + 2 * k + 2 : 0};
            pg8::Gemm gp{(const bf16*)(ws + WS_PE), (const bf16*)(ws + WS_WPP), MP, D, DPLE}; pg8::EpiBf Ep{PRJ};
            pg8::gemm_phase<pg8::EpiBf, pg8::RangeOrder, true, true>(F.lds, gp, R, Ep);
        }
    } SEAM(6);
    if (IN(7)) {
        pg8::Gemm g{ACT, (const bf16*)(ws + WS_W2D), MP, D, FF}; pg8::StaticOrder S; S.init(MP, D, F.G, (int)blockIdx.x);
        pg8::EpiRes E{XG, SS, 0.5f};
        pg8::gemm_phase<pg8::EpiRes, pg8::StaticOrder, true, true>(F.lds, g, S, E);
        ElemRes Es{XG, SS, 0.5f};
        gemm_sample_rows<ElemRes>(F, ACT, (const bf16*)(ws + WS_W2D), FF, Es);
    } SEAM(7);
    if (IN(8)) {
        pg8::Gemm g{(const bf16*)(ws + WS_PE), (const bf16*)(ws + WS_WPP), MP, D, DPLE}; pg8::StaticOrder S; S.init(MP, D, F.G, (int)blockIdx.x);
        pg8::EpiBf E{PRJ};
        if (!spread) pg8::gemm_phase<pg8::EpiBf, pg8::StaticOrder, true, true>(F.lds, g, S, E);
        ElemBf Es{PRJ};
        gemm_sample_rows<ElemBf>(F, (const bf16*)(ws + WS_PE), (const bf16*)(ws + WS_WPP), DPLE, Es);
        asm volatile("s_waitcnt vmcnt(0)" ::: "memory"); __syncthreads();
    }
    if (IN(8)) {
        pg8::Gemm g{XG, (const bf16*)(ws + WS_WPG), MP, D, D}; pg8::StaticOrder S; S.init(MP, D, F.G, (int)blockIdx.x);
        pg8::EpiPle E{XG, PRJ, F.out + OUT_Y, SS};
        pg8::gemm_phase<pg8::EpiPle, pg8::StaticOrder, true, true>(F.lds, g, S, E);
        ElemPle Es{XG, PRJ, F.out + OUT_Y, SS};
        gemm_sample_rows<ElemPle>(F, XG, (const bf16*)(ws + WS_WPG), D, Es);
    }
#undef IN
#undef SEAM
}

#ifndef MK_N_LAUNCHES
#define MK_N_LAUNCHES 1
#endif
extern "C" void kernel_launch(void* const* d_in, const int* in_sizes, int n_in, void* d_out, int out_size, void* d_ws, size_t ws_size, hipStream_t stream) {
    static int grid = 0;
    if (grid == 0) {
        if (n_in != 29 || out_size != (int)OUT_END || ws_size < WS_TOP) { fprintf(stderr, "kernel_launch: unexpected shapes (n_in %d out %d ws %zu)\n", n_in, out_size, ws_size); grid = -1; return; }
        int dev = 0, cus = 0, per_cu = 0;
        hipGetDevice(&dev); hipDeviceGetAttribute(&cus, hipDeviceAttributeMultiprocessorCount, dev);
        if (hipFuncSetAttribute((const void*)fwd_megakernel, hipFuncAttributeMaxDynamicSharedMemorySize, LDS_BYTES) != hipSuccess) { fprintf(stderr, "kernel_launch: hipFuncSetAttribute failed\n"); grid = -1; return; }
        if (hipOccupancyMaxActiveBlocksPerMultiprocessor(&per_cu, (const void*)fwd_megakernel, NWAVES * 64, LDS_BYTES) != hipSuccess || per_cu < 1) { fprintf(stderr, "kernel_launch: occupancy query says %d\n", per_cu); per_cu = 1; }
        (void)hipGetLastError();
        grid = cus * per_cu;
        fprintf(stderr, "kernel_launch: grid %d (cus %d x %d)\n", grid, cus, per_cu);
    }
    if (grid < 0) return;
    Args a{};
    for (int i = 0; i < 29; ++i) a.in[i] = (const float*)d_in[i];
    a.out = (float*)d_out; a.ws = (unsigned char*)d_ws;
    if (hipMemsetAsync((char*)d_ws + WS_CTL, 0, CTL_BYTES, stream) != hipSuccess) { fprintf(stderr, "kernel_launch: memset failed\n"); return; }
    if (MK_N_LAUNCHES == 1) {
        a.ph_lo = 0; a.ph_hi = 9;
        void* kargs[] = {&a};
        const hipError_t e = hipLaunchCooperativeKernel((const void*)fwd_megakernel, dim3(grid), dim3(NWAVES * 64), kargs, LDS_BYTES, stream);
        if (e != hipSuccess) fprintf(stderr, "kernel_launch: cooperative launch failed: %s (grid %d)\n", hipGetErrorString(e), grid);
    } else {
        for (int p = 0; p < 9; ++p) { a.ph_lo = p; a.ph_hi = p + 1; hipLaunchKernelGGL(fwd_megakernel, dim3(grid), dim3(NWAVES * 64), LDS_BYTES, stream, a); }
    }
}
```
